# Optimizing an MI355X kernel written in HIP

```python
import math
import jax, jax.numpy as jnp
from jax import lax
import numpy as np

D_MODEL = 1024
BATCH = 16
SEQ = 2048
DEPTH = 1

MLA_HEADS = 8
MLA_Q_RANK = 384
MLA_KV_RANK = 256
MLA_NOPE = 64
MLA_ROPE = 32
MLA_V = 64
ROPE_BASE = 10000.0
DIFF_HEADS = 4
DIFF_D = 64
IN_SPLITS = (MLA_Q_RANK, MLA_KV_RANK, MLA_ROPE,
             2 * DIFF_HEADS * DIFF_D, 2 * DIFF_HEADS * DIFF_D, DIFF_HEADS * 2 * DIFF_D)
IN_WIDTH = sum(IN_SPLITS)
IN_OFFSETS = tuple(int(v) for v in np.cumsum(IN_SPLITS)[:-1])
REL_BUCKETS = 32
REL_MAX_DIST = 128
MEM_LEN = 256
MEM_HEADS = 4
MEM_HEAD_DIM = D_MODEL // MEM_HEADS
D_FF = 2816
Q_BLOCK = 128
ALPHA = (2.0 * DEPTH) ** 0.25
BETA = (8.0 * DEPTH) ** -0.25
LN_EPS = 1e-5
RMS_EPS = 1e-6

kernel_name = "hybrid_mla_diffattn_macaron_deepnorm"


def layer_norm(x, g, b):
    xf = x.astype(jnp.float32)
    mu = jnp.mean(xf, axis=-1, keepdims=True)
    var = jnp.mean(jnp.square(xf - mu), axis=-1, keepdims=True)
    y = (xf - mu) * lax.rsqrt(var + LN_EPS) * g.astype(jnp.float32) + b.astype(jnp.float32)
    return y.astype(x.dtype)


def rms_norm(x, g):
    xf = x.astype(jnp.float32)
    y = xf * lax.rsqrt(jnp.mean(jnp.square(xf), axis=-1, keepdims=True) + RMS_EPS)
    return (y * g.astype(jnp.float32)).astype(x.dtype)


def swiglu(x, w1, w3, w2):
    return (jax.nn.silu(x @ w1) * (x @ w3)) @ w2


def rope(x, cos, sin):
    half = x.shape[-1] // 2
    x1, x2 = x[..., :half], x[..., half:]
    c, s = cos[None, :, None, :], sin[None, :, None, :]
    return jnp.concatenate([x1 * c - x2 * s, x2 * c + x1 * s], axis=-1)


def t5_bucket(q_pos, k_pos):
    n = jnp.maximum(q_pos[:, None] - k_pos[None, :], 0)
    max_exact = REL_BUCKETS // 2
    nf = jnp.maximum(n, 1).astype(jnp.float32)
    large = max_exact + (jnp.log(nf / max_exact) / math.log(REL_MAX_DIST / max_exact)
                         * (REL_BUCKETS - max_exact)).astype(jnp.int32)
    large = jnp.minimum(large, REL_BUCKETS - 1)
    return jnp.where(n < max_exact, n, large)


def parallel_mixer(h, rel_bias, w_in, q_norm_g, kv_norm_g, w_q_b, w_kv_b,
                   lam_q1, lam_k1, lam_q2, lam_k2, lam_init, diff_norm_g,
                   w_gate, b_gate, w_up_mla, w_up_diff, w_o):
    B, S, _ = h.shape
    proj = h @ w_in
    c_q, c_kv, k_rope, q_d, k_d, v_d = jnp.split(proj, IN_OFFSETS, axis=-1)

    q = (rms_norm(c_q, q_norm_g) @ w_q_b).reshape(B, S, MLA_HEADS, MLA_NOPE + MLA_ROPE)
    q_nope, q_rope = q[..., :MLA_NOPE], q[..., MLA_NOPE:]
    kv = (rms_norm(c_kv, kv_norm_g) @ w_kv_b).reshape(B, S, MLA_HEADS, MLA_NOPE + MLA_V)
    k_nope, v_m = kv[..., :MLA_NOPE], kv[..., MLA_NOPE:]
    pos = jnp.arange(S)
    inv_freq = ROPE_BASE ** (-jnp.arange(0, MLA_ROPE, 2, dtype=jnp.float32) / MLA_ROPE)
    ang = pos.astype(jnp.float32)[:, None] * inv_freq[None, :]
    cos, sin = jnp.cos(ang).astype(h.dtype), jnp.sin(ang).astype(h.dtype)
    q_rope = rope(q_rope, cos, sin)
    k_rope = rope(k_rope[:, :, None, :], cos, sin)[:, :, 0]

    q_d = q_d.reshape(B, S, 2 * DIFF_HEADS, DIFF_D)
    k_d = k_d.reshape(B, S, 2 * DIFF_HEADS, DIFF_D)
    v_d = v_d.reshape(B, S, DIFF_HEADS, 2 * DIFF_D)
    f32 = jnp.float32
    lam = (jnp.exp(jnp.sum(lam_q1.astype(f32) * lam_k1.astype(f32)))
           - jnp.exp(jnp.sum(lam_q2.astype(f32) * lam_k2.astype(f32))) + lam_init)

    mla_scale = (MLA_NOPE + MLA_ROPE) ** -0.5
    diff_scale = DIFF_D ** -0.5
    outs_m, outs_d = [], []
    for i in range(S // Q_BLOCK):
        lo, hi = i * Q_BLOCK, (i + 1) * Q_BLOCK
        q_pos = jnp.arange(lo, hi)
        k_pos = jnp.arange(hi)
        causal = q_pos[:, None] >= k_pos[None, :]
        s = (jnp.einsum('bqhd,bkhd->bhqk', q_nope[:, lo:hi], k_nope[:, :hi])
             + jnp.einsum('bqhr,bkr->bhqk', q_rope[:, lo:hi], k_rope[:, :hi]))
        p = jax.nn.softmax(jnp.where(causal, s.astype(f32) * mla_scale, -jnp.inf), axis=-1)
        outs_m.append(jnp.einsum('bhqk,bkhd->bqhd', p.astype(v_m.dtype), v_m[:, :hi]))
        bias = jnp.transpose(rel_bias[t5_bucket(q_pos, k_pos)], (2, 0, 1)).astype(f32)
        s = jnp.einsum('bqhd,bkhd->bhqk', q_d[:, lo:hi], k_d[:, :hi]).astype(f32) * diff_scale + bias
        p = jax.nn.softmax(jnp.where(causal, s, -jnp.inf), axis=-1)
        p = p.reshape(B, DIFF_HEADS, 2, Q_BLOCK, hi)
        a = p[:, :, 0] - lam * p[:, :, 1]
        outs_d.append(jnp.einsum('bhqk,bkhd->bqhd', a.astype(v_d.dtype), v_d[:, :hi]))

    o_m = jnp.concatenate(outs_m, axis=1).reshape(B, S, MLA_HEADS * MLA_V)
    o_d = jnp.concatenate(outs_d, axis=1)
    o_d = (rms_norm(o_d, diff_norm_g) * (1.0 - lam_init)).reshape(B, S, DIFF_HEADS * 2 * DIFF_D)

    y_m = o_m @ w_up_mla
    y_d = o_d @ w_up_diff
    g = jax.nn.sigmoid(h @ w_gate + b_gate)
    g_m, g_d = g[..., :D_MODEL], g[..., D_MODEL:]
    return (g_m * y_m + g_d * y_d) @ w_o


def memory_attention(h, mem, w_q, w_kv, w_o):
    B, S, _ = h.shape
    M = mem.shape[1]
    q = (h @ w_q).reshape(B, S, MEM_HEADS, MEM_HEAD_DIM)
    kv = mem @ w_kv
    k = kv[..., :D_MODEL].reshape(B, M, MEM_HEADS, MEM_HEAD_DIM)
    v = kv[..., D_MODEL:].reshape(B, M, MEM_HEADS, MEM_HEAD_DIM)
    s = jnp.einsum('bqhd,bkhd->bhqk', q, k).astype(jnp.float32) * MEM_HEAD_DIM ** -0.5
    p = jax.nn.softmax(s, axis=-1)
    o = jnp.einsum('bhqk,bkhd->bqhd', p.astype(v.dtype), v).reshape(B, S, D_MODEL)
    return o @ w_o


def setup_inputs(seed: int = 0) -> dict:
    key = jax.random.key(seed)
    ks = iter(jax.random.split(key, 64))
    L, D, F = DEPTH, D_MODEL, D_FF

    def dense(shape, fan_in, scale=1.0):
        return jax.random.normal(next(ks), shape, jnp.float32) * (fan_in ** -0.5) * scale

    def gain(shape):
        return 1.0 + 0.05 * jax.random.normal(next(ks), shape, jnp.float32)

    def small(shape, scale=0.05):
        return scale * jax.random.normal(next(ks), shape, jnp.float32)

    mla_in = MLA_HEADS * MLA_V
    diff_in = DIFF_HEADS * 2 * DIFF_D
    return {
        "x": jax.random.normal(next(ks), (BATCH, SEQ, D), jnp.float32),
        "mem": jax.random.normal(next(ks), (BATCH, MEM_LEN, D), jnp.float32),
        "rel_bias": small((REL_BUCKETS, 2 * DIFF_HEADS), 0.3),
        "ffn1_w1": dense((L, D, F), D),
        "ffn1_w3": dense((L, D, F), D),
        "ffn1_w2": dense((L, F, D), F, BETA),
        "ln1_g": gain((L, D)),
        "ln1_b": small((L, D)),
        "w_in": dense((L, D, IN_WIDTH), D),
        "q_norm_g": gain((L, MLA_Q_RANK)),
        "kv_norm_g": gain((L, MLA_KV_RANK)),
        "w_q_b": dense((L, MLA_Q_RANK, MLA_HEADS * (MLA_NOPE + MLA_ROPE)), MLA_Q_RANK),
        "w_kv_b": dense((L, MLA_KV_RANK, MLA_HEADS * (MLA_NOPE + MLA_V)), MLA_KV_RANK),
        "lam_q1": small((L, DIFF_D), 0.1),
        "lam_k1": small((L, DIFF_D), 0.1),
        "lam_q2": small((L, DIFF_D), 0.1),
        "lam_k2": small((L, DIFF_D), 0.1),
        "diff_norm_g": gain((L, 2 * DIFF_D)),
        "w_gate": dense((L, D, 2 * D), D),
        "b_gate": small((L, 2 * D), 0.1),
        "w_up_mla": dense((L, mla_in, D), mla_in, BETA),
        "w_up_diff": dense((L, diff_in, D), diff_in, BETA),
        "w_o": dense((L, D, D), D, BETA),
        "ln2_g": gain((L, D)),
        "ln2_b": small((L, D)),
        "mem_w_q": dense((L, D, D), D),
        "mem_w_kv": dense((L, D, 2 * D), D),
        "mem_w_o": dense((L, D, D), D, BETA),
        "ln3_g": gain((L, D)),
        "ln3_b": small((L, D)),
        "ffn2_w1": dense((L, D, F), D),
        "ffn2_w3": dense((L, D, F), D),
        "ffn2_w2": dense((L, F, D), F, BETA),
        "ln4_g": gain((L, D)),
        "ln4_b": small((L, D)),
    }


def reference(x, mem, rel_bias, ffn1_w1, ffn1_w3, ffn1_w2, ln1_g, ln1_b,
              w_in, q_norm_g, kv_norm_g, w_q_b, w_kv_b, lam_q1, lam_k1, lam_q2, lam_k2,
              diff_norm_g, w_gate, b_gate, w_up_mla, w_up_diff, w_o, ln2_g, ln2_b,
              mem_w_q, mem_w_kv, mem_w_o, ln3_g, ln3_b,
              ffn2_w1, ffn2_w3, ffn2_w2, ln4_g, ln4_b):
    h = x
    for l in range(DEPTH):
        lam_init = 0.8 - 0.6 * math.exp(-0.3 * l)
        h = layer_norm(ALPHA * h + 0.5 * swiglu(h, ffn1_w1[l], ffn1_w3[l], ffn1_w2[l]),
                       ln1_g[l], ln1_b[l])
        mix = parallel_mixer(h, rel_bias, w_in[l], q_norm_g[l], kv_norm_g[l], w_q_b[l], w_kv_b[l],
                             lam_q1[l], lam_k1[l], lam_q2[l], lam_k2[l], lam_init, diff_norm_g[l],
                             w_gate[l], b_gate[l], w_up_mla[l], w_up_diff[l], w_o[l])
        h = layer_norm(ALPHA * h + mix, ln2_g[l], ln2_b[l])
        h = layer_norm(ALPHA * h + memory_attention(h, mem, mem_w_q[l], mem_w_kv[l], mem_w_o[l]),
                       ln3_g[l], ln3_b[l])
        h = layer_norm(ALPHA * h + 0.5 * swiglu(h, ffn2_w1[l], ffn2_w3[l], ffn2_w2[l]),
                       ln4_g[l], ln4_b[l])
    return h
```

```cpp
#include <hip/hip_runtime.h>
#include <cstdio>
#include <cstdint>
namespace pg8 {
#define PG8_LAS __attribute__((address_space(3)))
typedef unsigned short bf16_t;
typedef short bf16x8 __attribute__((ext_vector_type(8)));
typedef float f32x4 __attribute__((ext_vector_type(4)));
typedef unsigned u32x4 __attribute__((ext_vector_type(4)));
constexpr int BM = 256, BK = 64, HALF = 128, HTB = HALF * BK * 2  , STAGE_BYTES = 8 * HTB, NXCD = 8, WGM = 8;

__host__ __device__ __forceinline__ int lds_byte(int r, int c) { const int st = (r >> 4) * 2 + (c >> 5), rr = r & 15, cc = c & 31, ob = rr * 64 + cc * 2; return st * 1024 + (ob ^ (((ob >> 9) & 1) << 5)); }
__host__ __device__ __forceinline__ void stage_rc(int b, int& R, int& C) { const int st = b / 1024, sb = b % 1024, swz = sb ^ (((sb >> 9) & 1) << 5); R = (st >> 1) * 16 + swz / 64; C = (st & 1) * 32 + (swz % 64) / 2; }
__host__ __device__ __forceinline__ int perm32(int rho) { const int n = rho >> 4, i = rho & 15; return 8 * (i >> 2) + 4 * n + (i & 3); }

struct Unit { int pm, pn; };
struct Gemm { const bf16_t* A; const bf16_t* Bt; int M, N, K; };

struct StaticOrder {
    int nM, nN, nwg, G, c;
    __host__ __device__ void init(int M, int N, int G_, int c_) { nM = M / BM; nN = N / BM; nwg = nM * nN; G = G_; c = c_; }
    __host__ __device__ bool next(int i, Unit& u) const {
        const long L = (long)i * G + c; if (L >= nwg) return false;
        int wgid = (int)L; { const int q = nwg / NXCD, r = nwg % NXCD, xcd = wgid % NXCD, off = wgid / NXCD; wgid = (xcd < r ? xcd * (q + 1) : r * (q + 1) + (xcd - r) * q) + off; }
        const int nig = WGM * nN, gid = wgid / nig, fm = gid * WGM, gsz = (nM - fm) < WGM ? (nM - fm) : WGM;
        u.pm = fm + ((wgid % nig) % gsz); u.pn = (wgid % nig) / gsz; return true;
    }
    __device__ __forceinline__ void a_ready(const Unit&) const {}
    __device__ __forceinline__ void done(const Unit&) const {}
};

__device__ __forceinline__ unsigned cvt_pk_bf16(float lo, float hi) { unsigned r; asm volatile("v_cvt_pk_bf16_f32 %0, %1, %2" : "=v"(r) : "v"(lo), "v"(hi)); return r; }
template <class Epi, class Sched, bool ALIGN_EPI = false, bool SP2 = false>
__device__ __forceinline__ void gemm_phase(PG8_LAS unsigned char* lds, const Gemm g, const Sched& S, const Epi& E, const unsigned* zero_word) {
    int tid_ = (int)(threadIdx.x | *(volatile __attribute__((address_space(1))) unsigned*)zero_word);
    const int tid = tid_, wid = __builtin_amdgcn_readfirstlane(tid >> 6), lane = tid & 63, wr = wid >> 2, wc = wid & 3, fr = lane & 15, fq = lane >> 4;
    const int K = g.K, nt = K / BK;
    unsigned voffA[2], voffB[2];
#pragma unroll
    for (int i = 0; i < 2; ++i) { int R, C; stage_rc(tid * 16 + i * 8192, R, C); const int Rb = Epi::PERM ? ((R & ~31) + perm32(R & 31)) : R;
        voffA[i] = (unsigned)(R * K + C) * 2u; voffB[i] = (unsigned)(Rb * K + C) * 2u; }
    const size_t kstep = (size_t)(BK * 2);
    const size_t hstep = (size_t)HALF * K * 2;
    const size_t tstep = 2 * hstep;
    const unsigned ldsw = (unsigned)wid * 1024u;
    const int aoff = lds_byte(wr * 64 + fr, fq * 8), boff = lds_byte(wc * 32 + fr, fq * 8);
#define PG8_SA(b, h) (((b) * 2 + (h)) * HTB)
#define PG8_SB(b, h) ((4 + (b) * 2 + (h)) * HTB)
#define PG8_STAGE(bufoff, gbase, voff) do { _Pragma("unroll") for (int _i = 0; _i < 2; ++_i) \
        __builtin_amdgcn_global_load_lds((const unsigned*)((const char*)(gbase) + (voff)[_i]), (PG8_LAS unsigned*)(lds + (bufoff) + ldsw + _i * 8192), 16, 0, 0); } while (0)
#define PG8_LDA(dst, b, h) do { _Pragma("unroll") for (int m = 0; m < 4; ++m) _Pragma("unroll") for (int k = 0; k < 2; ++k) dst[m][k] = *(const PG8_LAS bf16x8*)(lds + PG8_SA(b, h) + aoff + m * 2048 + k * 1024); } while (0)
#define PG8_LDB(dst, b, h) do { _Pragma("unroll") for (int n = 0; n < 2; ++n) _Pragma("unroll") for (int k = 0; k < 2; ++k) dst[n][k] = *(const PG8_LAS bf16x8*)(lds + PG8_SB(b, h) + boff + n * 2048 + k * 1024); } while (0)
#define PG8_MMA(ai, bj, At, Bt) do { __builtin_amdgcn_s_setprio(1); _Pragma("unroll") for (int m = 0; m < 4; ++m) _Pragma("unroll") for (int n = 0; n < 2; ++n) _Pragma("unroll") for (int k = 0; k < 2; ++k) \
        acc[ai][bj][m][n] = __builtin_amdgcn_mfma_f32_16x16x32_bf16(Bt[n][k], At[m][k], acc[ai][bj][m][n], 0, 0, 0); __builtin_amdgcn_s_setprio(0); } while (0)
#define PG8_WAIT_V(n) asm volatile("s_waitcnt vmcnt(" #n ")" ::: "memory")
#define PG8_WAIT_L(n) asm volatile("s_waitcnt lgkmcnt(" #n ")" ::: "memory")
#define PG8_BAR __builtin_amdgcn_s_barrier()
#define PG8_SCHED __builtin_amdgcn_sched_barrier(0)
    Unit cur, nxt; int ui = 0;
    if (!S.next(0, cur)) return;
    f32x4 acc[2][2][4][2];
#pragma unroll
    for (int a = 0; a < 2; ++a)
#pragma unroll
        for (int b = 0; b < 2; ++b)
#pragma unroll
            for (int m = 0; m < 4; ++m)
#pragma unroll
                for (int n = 0; n < 2; ++n) acc[a][b][m][n] = (f32x4){0.f, 0.f, 0.f, 0.f};
    bf16x8 At[4][2], B0[2][2], B1[2][2];
    const char* cA = (const char*)g.A + (size_t)cur.pm * tstep; const char* cB = (const char*)g.Bt + (size_t)cur.pn * tstep;
    S.a_ready(cur);
    if constexpr (SP2) {
        PG8_STAGE(PG8_SB(0, 0), cB, voffB); PG8_STAGE(PG8_SB(0, 1), cB + hstep, voffB); PG8_STAGE(PG8_SA(0, 0), cA, voffA); PG8_STAGE(PG8_SA(0, 1), cA + hstep, voffA);
        if (wr == 1) PG8_BAR;
        PG8_WAIT_V(2); PG8_BAR;
        PG8_STAGE(PG8_SB(1, 0), cB + kstep, voffB); PG8_STAGE(PG8_SA(1, 0), cA + kstep, voffA); PG8_STAGE(PG8_SB(1, 1), cB + hstep + kstep, voffB);
        PG8_WAIT_V(6); PG8_BAR;
    } else {
        PG8_STAGE(PG8_SB(0, 0), cB, voffB); PG8_STAGE(PG8_SA(0, 0), cA, voffA); PG8_STAGE(PG8_SB(0, 1), cB + hstep, voffB); PG8_STAGE(PG8_SA(0, 1), cA + hstep, voffA);
        if (wr == 1) PG8_BAR;
        PG8_WAIT_V(4); PG8_BAR;
        PG8_STAGE(PG8_SB(1, 0), cB + kstep, voffB); PG8_STAGE(PG8_SA(1, 0), cA + kstep, voffA); PG8_STAGE(PG8_SB(1, 1), cB + hstep + kstep, voffB);
        PG8_WAIT_V(6); PG8_BAR;
    }
    for (;;) {
        const bool has_next = S.next(ui + 1, nxt);
        const char* nA = has_next ? (const char*)g.A + (size_t)nxt.pm * tstep : cA; const char* nB = has_next ? (const char*)g.Bt + (size_t)nxt.pn * tstep : cB;
_Pragma("nounroll")
        for (int t = 0; t < nt; t += 2) {
            const bool last = (t == nt - 2);
            const char* a1 = cA + (size_t)(t + 1) * kstep;
            const char* a2 = last ? nA : cA + (size_t)(t + 2) * kstep; const char* b2 = last ? nB : cB + (size_t)(t + 2) * kstep;
            const char* a3 = a2 + kstep; const char* b3 = b2 + kstep;
            if (last && has_next) S.a_ready(nxt);
            if constexpr (SP2) {
            PG8_LDB(B0, 0, 0); PG8_LDB(B1, 0, 1); PG8_SCHED; PG8_LDA(At, 0, 0); PG8_STAGE(PG8_SA(1, 1), a1 + hstep, voffA);
            PG8_WAIT_V(8); PG8_WAIT_L(0); PG8_BAR; PG8_MMA(0, 0, At, B0); PG8_MMA(0, 1, At, B1); PG8_BAR; PG8_SCHED;
            PG8_LDA(At, 0, 1); PG8_STAGE(PG8_SB(0, 0), b2, voffB); PG8_STAGE(PG8_SB(0, 1), b2 + hstep, voffB); PG8_STAGE(PG8_SA(0, 0), a2, voffA);
            PG8_WAIT_V(8); PG8_WAIT_L(0); PG8_BAR; PG8_MMA(1, 0, At, B0); PG8_MMA(1, 1, At, B1); PG8_BAR; PG8_SCHED;
            PG8_LDB(B0, 1, 0); PG8_LDB(B1, 1, 1); PG8_SCHED; PG8_LDA(At, 1, 0); PG8_STAGE(PG8_SA(0, 1), a2 + hstep, voffA);
            PG8_WAIT_V(8); PG8_WAIT_L(0); PG8_BAR; PG8_MMA(0, 0, At, B0); PG8_MMA(0, 1, At, B1); PG8_BAR; PG8_SCHED;
            PG8_LDA(At, 1, 1); PG8_STAGE(PG8_SB(1, 0), b3, voffB); PG8_STAGE(PG8_SB(1, 1), b3 + hstep, voffB); PG8_STAGE(PG8_SA(1, 0), a3, voffA);
            PG8_WAIT_V(8); PG8_WAIT_L(0); PG8_BAR; PG8_MMA(1, 0, At, B0); PG8_MMA(1, 1, At, B1); PG8_BAR; PG8_SCHED;
            } else {
            PG8_LDB(B0, 0, 0); PG8_SCHED; PG8_LDA(At, 0, 0); PG8_STAGE(PG8_SA(1, 1), a1 + hstep, voffA);
            PG8_WAIT_L(8); PG8_BAR; PG8_WAIT_L(0); PG8_MMA(0, 0, At, B0); PG8_BAR; PG8_SCHED;
            PG8_LDB(B1, 0, 1); PG8_STAGE(PG8_SB(0, 0), b2, voffB);
            PG8_BAR; PG8_WAIT_L(0); PG8_MMA(0, 1, At, B1); PG8_BAR;
            PG8_LDA(At, 0, 1); PG8_STAGE(PG8_SA(0, 0), a2, voffA);
            PG8_BAR; PG8_WAIT_L(0); PG8_MMA(1, 0, At, B0); PG8_BAR; PG8_SCHED;
            PG8_STAGE(PG8_SB(0, 1), b2 + hstep, voffB);
            PG8_WAIT_V(6); PG8_BAR; PG8_MMA(1, 1, At, B1); PG8_BAR;
            PG8_LDB(B0, 1, 0); PG8_SCHED; PG8_LDA(At, 1, 0); PG8_STAGE(PG8_SA(0, 1), a2 + hstep, voffA);
            PG8_WAIT_L(8); PG8_BAR; PG8_WAIT_L(0); PG8_MMA(0, 0, At, B0); PG8_BAR; PG8_SCHED;
            PG8_LDB(B1, 1, 1); PG8_STAGE(PG8_SB(1, 0), b3, voffB);
            PG8_BAR; PG8_WAIT_L(0); PG8_MMA(0, 1, At, B1); PG8_BAR;
            PG8_LDA(At, 1, 1); PG8_STAGE(PG8_SA(1, 0), a3, voffA);
            PG8_BAR; PG8_WAIT_L(0); PG8_MMA(1, 0, At, B0); PG8_BAR; PG8_SCHED;
            PG8_STAGE(PG8_SB(1, 1), b3 + hstep, voffB);
            PG8_WAIT_V(6); PG8_BAR; PG8_MMA(1, 1, At, B1); PG8_BAR;
            }
        }
        if constexpr (ALIGN_EPI) { if (wr == 0) PG8_BAR; }
        if constexpr (!Epi::AFTER_DRAIN) { E(acc, cur, wr, wc, fr, fq); S.done(cur); }
        if (!has_next) break;
#pragma unroll
        for (int a = 0; a < 2; ++a)
#pragma unroll
            for (int b = 0; b < 2; ++b)
#pragma unroll
                for (int m = 0; m < 4; ++m)
#pragma unroll
                    for (int n = 0; n < 2; ++n) acc[a][b][m][n] = (f32x4){0.f, 0.f, 0.f, 0.f};
        cur = nxt; cA = nA; cB = nB; ++ui;
        if constexpr (ALIGN_EPI) { if (wr == 1) PG8_BAR; }
    }
    PG8_WAIT_V(0);
    if constexpr (!ALIGN_EPI) { if (wr == 0) PG8_BAR; }
    PG8_BAR;
    if constexpr (Epi::AFTER_DRAIN) { E.fused(acc, cur, wr, wc, fr, fq, lds, wid, lane); S.done(cur); }
#undef PG8_SA
#undef PG8_SB
#undef PG8_STAGE
#undef PG8_LDA
#undef PG8_LDB
#undef PG8_MMA
#undef PG8_WAIT_V
#undef PG8_WAIT_L
#undef PG8_BAR
#undef PG8_SCHED
}
}

template <class F> struct EpiRow {
    static constexpr bool PERM = true, AFTER_DRAIN = false;
    F f;
    __device__ __forceinline__ void operator()(const pg8::f32x4 (&acc)[2][2][4][2], const pg8::Unit& u, int wr, int wc, int fr, int fq) const {
        const int rowb = u.pm * 256 + wr * 64 + fr, cb = wc * 32 + 8 * fq;
#pragma unroll
        for (int ai = 0; ai < 2; ++ai)
#pragma unroll
            for (int m = 0; m < 4; ++m) { f(rowb + ai * 128 + m * 16, u.pn, cb, acc[ai][0][m][0], acc[ai][0][m][1], acc[ai][1][m][0], acc[ai][1][m][1]); if (m & 1) asm volatile("" ::: "memory"); }
    }
};

#define GAS __attribute__((address_space(1)))
#define LAS __attribute__((address_space(3)))
typedef unsigned short bf16;
typedef unsigned v4u __attribute__((ext_vector_type(4)));
typedef unsigned v2u __attribute__((ext_vector_type(2)));
typedef float f32x4 __attribute__((ext_vector_type(4)));
typedef float f32x16 __attribute__((ext_vector_type(16)));
typedef short bf16x8 __attribute__((ext_vector_type(8)));
typedef short s16x4 __attribute__((ext_vector_type(4)));
typedef GAS unsigned gu32;
typedef GAS unsigned long long gu64;
#define RLX_AGENT __ATOMIC_RELAXED, __HIP_MEMORY_SCOPE_AGENT
#define LDS_WAIT() asm volatile("s_waitcnt lgkmcnt(0)" ::: "memory")
#define VM_WAIT() asm volatile("s_waitcnt vmcnt(0)" ::: "memory")
__device__ __forceinline__ unsigned f2bf(float f) { unsigned u = __builtin_bit_cast(unsigned, f); return (u + 0x7fffu + ((u >> 16) & 1u)) >> 16; }
__device__ __forceinline__ unsigned pk2(float lo, float hi) { return f2bf(lo) | (f2bf(hi) << 16); }
__device__ __forceinline__ float bf2f(unsigned short b) { return __builtin_bit_cast(float, (unsigned)b << 16); }
__device__ __forceinline__ unsigned cvtpk(float lo, float hi) { return pg8::cvt_pk_bf16(lo, hi); }
__device__ __forceinline__ v4u pack8(f32x4 a, f32x4 b) { v4u w; w.x = cvtpk(a[0], a[1]); w.y = cvtpk(a[2], a[3]); w.z = cvtpk(b[0], b[1]); w.w = cvtpk(b[2], b[3]); return w; }
__device__ __forceinline__ void unpack8(v4u w, f32x4& a, f32x4& b) {
    a[0] = __builtin_bit_cast(float, w.x << 16); a[1] = __builtin_bit_cast(float, w.x & 0xffff0000u); a[2] = __builtin_bit_cast(float, w.y << 16); a[3] = __builtin_bit_cast(float, w.y & 0xffff0000u);
    b[0] = __builtin_bit_cast(float, w.z << 16); b[1] = __builtin_bit_cast(float, w.z & 0xffff0000u); b[2] = __builtin_bit_cast(float, w.w << 16); b[3] = __builtin_bit_cast(float, w.w & 0xffff0000u); }
__device__ __forceinline__ float fexp2(float x) { return __builtin_amdgcn_exp2f(x); }
__device__ __forceinline__ float frcp(float x) { return __builtin_amdgcn_rcpf(x); }
__device__ __forceinline__ float sigmoidf_(float x) { return frcp(1.0f + fexp2(-1.4426950408889634f * x)); }
#define XB_TMO      128
#define XB_XCNT(j)  (256  + 64 * (j))
#define XB_XSUB(j)  (1280 + 64 * (j))
#define XB_XGEN(j)  (2304 + 64 * (j))
#define XB_TOP      3328
#define XB_TOPGEN   3392
#define XCD_BAR_WORDS 3456
#define XB_SPIN_CAP (1u << 18)

__device__ __forceinline__ unsigned xb_ld(unsigned* p)              { return __hip_atomic_load(p, __ATOMIC_RELAXED, __HIP_MEMORY_SCOPE_AGENT); }
__device__ __forceinline__ unsigned xb_add(unsigned* p, unsigned v) { return __hip_atomic_fetch_add(p, v, __ATOMIC_RELAXED, __HIP_MEMORY_SCOPE_AGENT); }
__device__ __forceinline__ unsigned xb_xcc_id() { return (unsigned)__builtin_amdgcn_s_getreg((3 << 11) | 20) & 0xFu; }
#define XB_SPIN(cond, bar) do { unsigned _sp = 0; while (cond) { __builtin_amdgcn_s_sleep(1); \
    if ((++_sp & 255u) == 0u) { if (xb_ld(&(bar)[XB_TMO])) break; if (_sp > XB_SPIN_CAP) { atomicAdd(&(bar)[XB_TMO], 1u); break; } } } } while (0)

struct XcdBarrier {
    unsigned* bar; unsigned x;
    volatile LAS unsigned* st;
};

__device__ __forceinline__ XcdBarrier xcd_barrier_post(unsigned* bar, volatile LAS unsigned* st) {
    XcdBarrier b; b.bar = bar; b.x = xb_xcc_id(); b.st = st;
    if (threadIdx.x == 0) (void)xb_add(&bar[XB_XCNT(b.x)], 1u);
    return b;
}
__device__ __forceinline__ void xcd_barrier_complete(unsigned* bar, unsigned x, unsigned& nloc, unsigned& nx) {
    const unsigned G = gridDim.x * gridDim.y * gridDim.z;
    unsigned sum, cnt, mine, sp = 0u;
    for (;;) {
        sum = 0u; cnt = 0u; mine = 0u;
#pragma unroll
        for (unsigned j = 0; j < 16; ++j) { const unsigned c = xb_ld(&bar[XB_XCNT(j)]); sum += c; cnt += (c > 0u) ? 1u : 0u; mine = (j == x) ? c : mine; }
        if (sum == G) break;
        __builtin_amdgcn_s_sleep(1);
        if ((++sp & 255u) == 0u) { if (xb_ld(&bar[XB_TMO])) break; if (sp > XB_SPIN_CAP) { atomicAdd(&bar[XB_TMO], 1u); break; } }
    }
    nloc = mine > 0u ? mine : 1u; nx = cnt > 0u ? cnt : 1u;
}

__device__ __forceinline__ void xcd_barrier(const XcdBarrier& b) {
    asm volatile("s_waitcnt vmcnt(0)" ::: "memory");
    __syncthreads();
    if (threadIdx.x == 0) {
        unsigned* bar = b.bar;
        __builtin_amdgcn_s_waitcnt(0);
        unsigned nloc = b.st[0], nx = b.st[1];
        if (nloc == 0u) { xcd_barrier_complete(bar, b.x, nloc, nx); b.st[0] = nloc; b.st[1] = nx; }
        const unsigned old = xb_add(&bar[XB_XSUB(b.x)], 1u);
        const unsigned gen = old / nloc;
        if (old + 1u == (gen + 1u) * nloc) {
            __builtin_amdgcn_fence(__ATOMIC_RELEASE, "agent");
            asm volatile("s_waitcnt vmcnt(0)" ::: "memory");
            const unsigned og = xb_add(&bar[XB_TOP], 1u);
            const unsigned tg = og / nx;
            if (og + 1u == (tg + 1u) * nx) xb_add(&bar[XB_TOPGEN], 1u);
            else XB_SPIN(xb_ld(&bar[XB_TOPGEN]) == tg, bar);
            __builtin_amdgcn_fence(__ATOMIC_ACQUIRE, "agent");
            xb_add(&bar[XB_XGEN(b.x)], 1u);
            asm volatile("s_waitcnt vmcnt(0)" ::: "memory");
        } else {
            XB_SPIN(xb_ld(&bar[XB_XGEN(b.x)]) == gen, bar);
            __builtin_amdgcn_fence(__ATOMIC_ACQUIRE, "agent");
            asm volatile("s_waitcnt vmcnt(0)" ::: "memory");
        }
    }
    __syncthreads();
}

constexpr int NWAVES = 8;
#ifndef MK_ONE_LAUNCH
#define MK_ONE_LAUNCH 0
#endif
constexpr int BATCH = 16, SEQ = 2048, D = 1024, M = BATCH * SEQ, FF = 2816, MEML = 256, MM = BATCH * MEML;
constexpr int NPROJ = 2304, NPG = NPROJ + 2048;
constexpr int QR = 384, KVR = 256;
constexpr float LN_EPS = 1e-5f, RMS_EPS = 1e-6f;
constexpr float ALPHA = 1.189207115002721f;
constexpr float LOG2E = 1.4426950408889634f;
constexpr float C2_MLA = 0.10206207261596577f * LOG2E;
constexpr float C2_DIFF = 0.125f * LOG2E;
constexpr float C2_MEM = 0.0625f * LOG2E;
constexpr float LAM_INIT = 0.2f;
constexpr int NPHASE = 17;
enum { PH_PRO = 0, PH_FFN1UP, PH_FFN1DN, PH_LN1, PH_PROJ, PH_QKVUP, PH_ATTN, PH_YG, PH_WO, PH_LN2, PH_MEMQ, PH_MEMATT, PH_MEMO, PH_LN3, PH_FFN2UP, PH_FFN2DN, PH_LN4 };

constexpr size_t MiB = 1u << 20;
constexpr size_t WS_CTL = 0, CTL_ZERO_BYTES = 1 * MiB;
constexpr size_t WS_W1C1 = 1 * MiB, WS_W21 = 12 * MiB, WS_W1C2 = 18 * MiB, WS_W22 = 29 * MiB, WS_WPG = 35 * MiB, WS_WQB = 44 * MiB, WS_WKVB = 45 * MiB, WS_WY = 46 * MiB,
                 WS_WO = 50 * MiB, WS_WMQ = 52 * MiB, WS_WMKV = 54 * MiB, WS_WMO = 58 * MiB;
constexpr size_t WS_TAB = 60 * MiB;
constexpr size_t WS_SSQQ = 61 * MiB, WS_SSQKV = 62 * MiB;
constexpr size_t WS_KVM = 63 * MiB;
constexpr size_t WS_HF = 80 * MiB;
constexpr size_t WS_HB = 208 * MiB;
constexpr size_t WS_U = 272 * MiB;
constexpr size_t WS_G = 272 * MiB, WS_QM = 272 * MiB, WS_OMEM = 336 * MiB;
constexpr size_t WS_QD = 400 * MiB, WS_KD = 432 * MiB, WS_VD = 464 * MiB;
constexpr size_t WS_KROPE = 496 * MiB, WS_MEMB = 498 * MiB, WS_END = 512 * MiB;
constexpr size_t OUT_CQ = 0, OUT_CKV = 24 * MiB, OUT_QMLA = 80 * MiB, OUT_OMD = 0;
constexpr int CW_BAR = 4096;

constexpr int RING_OFF = 0, RING_BYTES = 131072;
constexpr int LDSCTL_OFF = RING_BYTES, MISC_OFF = LDSCTL_OFF + 320;
constexpr int LDS_BYTES = 147456;

__device__ __forceinline__ float wave_sum(float v) {
#pragma unroll
    for (int o = 1; o < 64; o <<= 1) v += __shfl_xor(v, o);
    return v;
}

__device__ __forceinline__ int ropepos(int i) { return i < 16 ? 8 * (i >> 2) + (i & 3) : 8 * ((i - 16) >> 2) + 4 + (i & 3); }
template <int MODE> __device__ __forceinline__ int rowmap(int n) {
    if constexpr (MODE == 0) return n;
    else if constexpr (MODE == 1) return 256 * (n >> 7) + (n & 127);
    else if constexpr (MODE == 2) return 256 * (n >> 7) + 128 + (n & 127);
    else if constexpr (MODE == 3) {
        if (n < 384) return n; if (n < 640) return 512 + (n - 384); if (n < 672) return 384 + ropepos(n - 640);
        if (n < 1184) return 768 + (n - 672); if (n < 1696) return 1280 + (n - 1184); return 1792 + (n - 1696); }
    else if constexpr (MODE == 4) return NPROJ + n;
    else if constexpr (MODE == 5) { const int h = n / 96, j = n - 96 * h; return j < 64 ? n : 96 * h + 64 + ropepos(j - 64); }
    else { const int h = n >> 7, j = n & 127; return j < 64 ? 64 * h + j : 512 + 64 * h + (j - 64); }
}
template <int MODE> __device__ __forceinline__ void p0_tr_item(const float* W, int K, int N, bf16* WT, int ldk, int koff, const float* kscale, LAS float* scr, int item, int lane) {
    const int nblk = N / 32, kb = item / nblk, nb = item % nblk, k0 = 64 * kb, n0 = 32 * nb;
#pragma unroll 8
    for (int i = 0; i < 32; ++i) { const int kk = 2 * i + (lane >> 5); float v = W[(size_t)(k0 + kk) * N + n0 + (lane & 31)]; if (kscale) v *= kscale[k0 + kk]; scr[kk * 33 + (lane & 31)] = v; }
    LDS_WAIT(); asm volatile("" ::: "memory");
    const int c = lane & 7;
#pragma unroll
    for (int j = 0; j < 4; ++j) { const int n = (lane >> 3) + 8 * j; const LAS float* s = scr + (8 * c) * 33 + n;
        v4u o; o.x = pk2(s[0 * 33], s[1 * 33]); o.y = pk2(s[2 * 33], s[3 * 33]); o.z = pk2(s[4 * 33], s[5 * 33]); o.w = pk2(s[6 * 33], s[7 * 33]);
        *(GAS v4u*)(WT + (size_t)rowmap<MODE>(n0 + n) * ldk + koff + k0 + 8 * c) = o; }
    LDS_WAIT(); asm volatile("" ::: "memory");
}

struct Ptrs {
    const float* in[35]; float* out; unsigned char* ws;
};
#define IN_X 0
#define IN_MEM 1
#define IN_RELB 2
#define IN_F1W1 3
#define IN_F1W3 4
#define IN_F1W2 5
#define IN_LN1G 6
#define IN_LN1B 7
#define IN_WIN 8
#define IN_QNG 9
#define IN_KVNG 10
#define IN_WQB 11
#define IN_WKVB 12
#define IN_LQ1 13
#define IN_LK1 14
#define IN_LQ2 15
#define IN_LK2 16
#define IN_DNG 17
#define IN_WGATE 18
#define IN_BGATE 19
#define IN_WUM 20
#define IN_WUD 21
#define IN_WOUT 22
#define IN_LN2G 23
#define IN_LN2B 24
#define IN_MWQ 25
#define IN_MWKV 26
#define IN_MWO 27
#define IN_LN3G 28
#define IN_LN3B 29
#define IN_F2W1 30
#define IN_F2W3 31
#define IN_F2W2 32
#define IN_LN4G 33
#define IN_LN4B 34

__device__ __forceinline__ void p0_prologue(const float* const* in, unsigned char* ws, LAS unsigned char* lds, int vcu, int G, int wave, int lane, int tid) {
    LAS float* scr = (LAS float*)(lds + RING_OFF + wave * 16384);
    const int gw = vcu * NWAVES + wave, NGW = G * NWAVES;
    constexpr int I_UP = (D / 64) * (FF / 32), I_DN = (FF / 64) * (D / 32), I_IN = (D / 64) * (2208 / 32), I_G = (D / 64) * (2048 / 32), I_QB = (QR / 64) * (768 / 32), I_KVB = (KVR / 64) * (1024 / 32),
                  I_Y = (512 / 64) * (D / 32), I_SQ = (D / 64) * (D / 32), I_MKV = (D / 64) * (2048 / 32);
    constexpr int NITEMS = 4 * I_UP + 2 * I_DN + I_IN + I_G + I_QB + I_KVB + 2 * I_Y + 3 * I_SQ + I_MKV;
    for (int it = gw; it < NITEMS; it += NGW) {
        int r = it;
        if (r < I_UP) { p0_tr_item<1>(in[IN_F1W1], D, FF, (bf16*)(ws + WS_W1C1), D, 0, nullptr, scr, r, lane); continue; } r -= I_UP;
        if (r < I_UP) { p0_tr_item<2>(in[IN_F1W3], D, FF, (bf16*)(ws + WS_W1C1), D, 0, nullptr, scr, r, lane); continue; } r -= I_UP;
        if (r < I_DN) { p0_tr_item<0>(in[IN_F1W2], FF, D, (bf16*)(ws + WS_W21), FF, 0, nullptr, scr, r, lane); continue; } r -= I_DN;
        if (r < I_UP) { p0_tr_item<1>(in[IN_F2W1], D, FF, (bf16*)(ws + WS_W1C2), D, 0, nullptr, scr, r, lane); continue; } r -= I_UP;
        if (r < I_UP) { p0_tr_item<2>(in[IN_F2W3], D, FF, (bf16*)(ws + WS_W1C2), D, 0, nullptr, scr, r, lane); continue; } r -= I_UP;
        if (r < I_DN) { p0_tr_item<0>(in[IN_F2W2], FF, D, (bf16*)(ws + WS_W22), FF, 0, nullptr, scr, r, lane); continue; } r -= I_DN;
        if (r < I_IN) { p0_tr_item<3>(in[IN_WIN], D, 2208, (bf16*)(ws + WS_WPG), D, 0, nullptr, scr, r, lane); continue; } r -= I_IN;
        if (r < I_G) { p0_tr_item<4>(in[IN_WGATE], D, 2048, (bf16*)(ws + WS_WPG), D, 0, nullptr, scr, r, lane); continue; } r -= I_G;
        if (r < I_QB) { p0_tr_item<5>(in[IN_WQB], QR, 768, (bf16*)(ws + WS_WQB), QR, 0, in[IN_QNG], scr, r, lane); continue; } r -= I_QB;
        if (r < I_KVB) { p0_tr_item<6>(in[IN_WKVB], KVR, 1024, (bf16*)(ws + WS_WKVB), KVR, 0, in[IN_KVNG], scr, r, lane); continue; } r -= I_KVB;
        if (r < I_Y) { p0_tr_item<1>(in[IN_WUM], 512, D, (bf16*)(ws + WS_WY), D, 0, nullptr, scr, r, lane); continue; } r -= I_Y;
        if (r < I_Y) { p0_tr_item<2>(in[IN_WUD], 512, D, (bf16*)(ws + WS_WY), D, 512, nullptr, scr, r, lane); continue; } r -= I_Y;
        if (r < I_SQ) { p0_tr_item<0>(in[IN_WOUT], D, D, (bf16*)(ws + WS_WO), D, 0, nullptr, scr, r, lane); continue; } r -= I_SQ;
        if (r < I_SQ) { p0_tr_item<0>(in[IN_MWQ], D, D, (bf16*)(ws + WS_WMQ), D, 0, nullptr, scr, r, lane); continue; } r -= I_SQ;
        if (r < I_MKV) { p0_tr_item<0>(in[IN_MWKV], D, 2048, (bf16*)(ws + WS_WMKV), D, 0, nullptr, scr, r, lane); continue; } r -= I_MKV;
        p0_tr_item<0>(in[IN_MWO], D, D, (bf16*)(ws + WS_WMO), D, 0, nullptr, scr, r, lane);
    }
    const int gt = vcu * (NWAVES * 64) + tid, NGT = G * NWAVES * 64;
    const v4u zero4 = {0u, 0u, 0u, 0u};
    for (int i = gt; i < 2048 * 64; i += NGT) { const int row = i >> 6, ch = i & 63; *(GAS v4u*)((bf16*)(ws + WS_WY) + (size_t)row * D + ((row & 128) ? 0 : 512) + ch * 8) = zero4; }
    for (int i = gt; i < 96 * 128; i += NGT) { const int row = 416 + (i >> 7), ch = i & 127; *(GAS v4u*)((bf16*)(ws + WS_WPG) + (size_t)row * D + ch * 8) = zero4; }
    { const GAS f32x4* x4 = (const GAS f32x4*)in[IN_X]; GAS v4u* o = (GAS v4u*)(ws + WS_HB);
      for (int i = gt; i < M * D / 8; i += NGT) { const f32x4 a = x4[2 * i], b = x4[2 * i + 1]; o[i] = pack8(a, b); }
      const GAS f32x4* m4 = (const GAS f32x4*)in[IN_MEM]; GAS v4u* om = (GAS v4u*)(ws + WS_MEMB);
      for (int i = gt; i < MM * D / 8; i += NGT) { const f32x4 a = m4[2 * i], b = m4[2 * i + 1]; om[i] = pack8(a, b); } }
    { float* tab = (float*)(ws + WS_TAB);
      for (int i = gt; i < SEQ * 16; i += NGT) { const int pos = i >> 4, k = i & 15;
          const double fr[16] = {1.0, 0.5623413251903491, 0.31622776601683794, 0.1778279410038923, 0.1, 0.05623413251903491, 0.03162277660168379, 0.01778279410038923, 0.01, 0.005623413251903491,
                                 0.0031622776601683794, 0.0017782794100389228, 0.001, 0.0005623413251903491, 0.00031622776601683794, 0.00017782794100389227};
          double f = 1.0;
#pragma unroll
          for (int q = 0; q < 16; ++q) f = (k == q) ? fr[q] : f;
          const double t = (double)pos * f * 0.15915494309189535;
          const float frac = (float)(t - __builtin_floor(t));
          tab[2 * i] = __builtin_amdgcn_cosf(frac); tab[2 * i + 1] = __builtin_amdgcn_sinf(frac); }
      float* bt = (float*)(ws + WS_TAB + 256 * 1024);
      for (int i = gt; i < 8 * 128; i += NGT) { const int mp = i >> 7, n = i & 127;
          int bk = n; if (n >= 16) { bk = 16 + (int)(__builtin_amdgcn_logf((float)n * 0.0625f) * (16.0f / 3.0f)); bk = bk > 31 ? 31 : bk; }
          bt[i] = (in[IN_RELB][bk * 8 + mp] - in[IN_RELB][31 * 8 + mp]) * LOG2E; }
      if (gt < 64) { const float a = in[IN_LQ1][gt] * in[IN_LK1][gt], b = in[IN_LQ2][gt] * in[IN_LK2][gt]; const float s1 = wave_sum(a), s2 = wave_sum(b);
          if (gt == 0) ((float*)(ws + WS_TAB + 260 * 1024))[0] = fexp2(s1 * LOG2E) - fexp2(s2 * LOG2E) + LAM_INIT; } }
}

__device__ __forceinline__ void ln_rows(const float* Z, const float* g, const float* b, float* HF, bf16* HB, int gw, int NGW, int lane) {
    f32x4 gv[4], bv[4];
#pragma unroll
    for (int j = 0; j < 4; ++j) { gv[j] = ((const GAS f32x4*)g)[lane + 64 * j]; bv[j] = ((const GAS f32x4*)b)[lane + 64 * j]; }
    for (int m = gw; m < M; m += NGW) {
        const GAS f32x4* xr = (const GAS f32x4*)(Z + (size_t)m * D) + lane;
        f32x4 v[4]; float s = 0.f;
#pragma unroll
        for (int j = 0; j < 4; ++j) { v[j] = xr[64 * j]; s += (v[j].x + v[j].y) + (v[j].z + v[j].w); }
        const float mean = wave_sum(s) * (1.f / D); float s2 = 0.f;
#pragma unroll
        for (int j = 0; j < 4; ++j) { v[j] = v[j] - mean; s2 += (v[j].x * v[j].x + v[j].y * v[j].y) + (v[j].z * v[j].z + v[j].w * v[j].w); }
        const float rstd = 1.f / sqrtf(wave_sum(s2) * (1.f / D) + LN_EPS);
        GAS f32x4* of = (GAS f32x4*)(HF + (size_t)m * D) + lane;
#pragma unroll
        for (int j = 0; j < 4; ++j) { v[j] = v[j] * rstd * gv[j] + bv[j]; of[64 * j] = v[j]; }
        if (HB) { GAS v2u* o8 = (GAS v2u*)(HB + (size_t)m * D) + lane;
#pragma unroll
            for (int j = 0; j < 4; ++j) { v2u w; w.x = cvtpk(v[j].x, v[j].y); w.y = cvtpk(v[j].z, v[j].w); o8[64 * j] = w; } }
    }
}

struct FSwiglu {
    bf16* U;
    __device__ __forceinline__ void operator()(int row, int pn, int cb, f32x4 a0, f32x4 a1, f32x4 b0, f32x4 b1) const {
        f32x4 r0, r1;
#pragma unroll
        for (int e = 0; e < 4; ++e) { r0[e] = a0[e] * sigmoidf_(a0[e]) * b0[e]; r1[e] = a1[e] * sigmoidf_(a1[e]) * b1[e]; }
        *(GAS v4u*)(U + (size_t)row * FF + 128 * pn + cb) = pack8(r0, r1);
    }
};
struct FResid {
    const float* base; float* Z; float s;
    __device__ __forceinline__ void operator()(int row, int pn, int cb, f32x4 a0, f32x4 a1, f32x4 b0, f32x4 b1) const {
        const size_t o = (size_t)row * D + 256 * pn + cb;
        const f32x4 x0 = *(const GAS f32x4*)(base + o), x1 = *(const GAS f32x4*)(base + o + 4), y0 = *(const GAS f32x4*)(base + o + 128), y1 = *(const GAS f32x4*)(base + o + 132);
        *(GAS f32x4*)(Z + o) = x0 * ALPHA + a0 * s; *(GAS f32x4*)(Z + o + 4) = x1 * ALPHA + a1 * s;
        *(GAS f32x4*)(Z + o + 128) = y0 * ALPHA + b0 * s; *(GAS f32x4*)(Z + o + 132) = y1 * ALPHA + b1 * s;
    }
};
struct FPlain {
    bf16* O; int ldc; float s;
    __device__ __forceinline__ void operator()(int row, int pn, int cb, f32x4 a0, f32x4 a1, f32x4 b0, f32x4 b1) const {
        bf16* p = O + (size_t)row * ldc + 256 * pn + cb;
        *(GAS v4u*)p = pack8(a0 * s, a1 * s); *(GAS v4u*)(p + 128) = pack8(b0 * s, b1 * s);
    }
};
__device__ __forceinline__ float ssq8(f32x4 a, f32x4 b) { return (a[0] * a[0] + a[1] * a[1]) + (a[2] * a[2] + a[3] * a[3]) + (b[0] * b[0] + b[1] * b[1]) + (b[2] * b[2] + b[3] * b[3]); }
__device__ __forceinline__ float red_fq(float s) { s += __shfl_xor(s, 16); s += __shfl_xor(s, 32); return s; }
__device__ __forceinline__ void rope8(f32x4& x1, f32x4& x2, const float* tabrow, int g) {
    const GAS f32x4* t = (const GAS f32x4*)(tabrow + 8 * g);
    const f32x4 t0 = t[0], t1 = t[1];
    f32x4 o1, o2;
    o1[0] = x1[0] * t0[0] - x2[0] * t0[1]; o2[0] = x2[0] * t0[0] + x1[0] * t0[1];
    o1[1] = x1[1] * t0[2] - x2[1] * t0[3]; o2[1] = x2[1] * t0[2] + x1[1] * t0[3];
    o1[2] = x1[2] * t1[0] - x2[2] * t1[1]; o2[2] = x2[2] * t1[0] + x1[2] * t1[1];
    o1[3] = x1[3] * t1[2] - x2[3] * t1[3]; o2[3] = x2[3] * t1[2] + x1[3] * t1[3];
    x1 = o1; x2 = o2;
}
struct FProj {
    bf16 *CQ, *CKV, *KROPE, *QKVD, *G; float *SSQQ, *SSQKV; const float* bgate; const float* rtab;
    __device__ __forceinline__ void operator()(int row, int pn, int cb, f32x4 a0, f32x4 a1, f32x4 b0, f32x4 b1) const {
        const int wc = cb >> 5, fq = (cb >> 3) & 3;
        if (pn == 0) {
            bf16* p = CQ + (size_t)row * QR + cb; *(GAS v4u*)p = pack8(a0, a1); *(GAS v4u*)(p + 128) = pack8(b0, b1);
            const float s = red_fq(ssq8(a0, a1) + ssq8(b0, b1)); if (fq == 0) SSQQ[(size_t)row * 8 + wc] = s;
        } else if (pn == 1) {
            *(GAS v4u*)(CQ + (size_t)row * QR + 256 + cb) = pack8(a0, a1);
            const float s = red_fq(ssq8(a0, a1)); if (fq == 0) SSQQ[(size_t)row * 8 + 4 + wc] = s;
            if (wc == 0) { rope8(b0, b1, rtab + (size_t)(row & (SEQ - 1)) * 32, fq); *(GAS v4u*)(KROPE + (size_t)row * 32 + cb) = pack8(b0, b1); }
        } else if (pn == 2) {
            bf16* p = CKV + (size_t)row * KVR + cb; *(GAS v4u*)p = pack8(a0, a1); *(GAS v4u*)(p + 128) = pack8(b0, b1);
            const float s = red_fq(ssq8(a0, a1) + ssq8(b0, b1)); if (fq == 0) SSQKV[(size_t)row * 4 + wc] = s;
        } else if (pn < 9) {
            const int t = pn - 3; bf16* base = QKVD + (size_t)(t >> 1) * ((size_t)M * 512); const float sc = t < 2 ? C2_DIFF : 1.0f;
            bf16* p = base + (size_t)row * 512 + 256 * (t & 1) + cb; *(GAS v4u*)p = pack8(a0 * sc, a1 * sc); *(GAS v4u*)(p + 128) = pack8(b0 * sc, b1 * sc);
        } else {
            const int c0 = 256 * (pn - 9) + cb;
            const f32x4 ba0 = *(const GAS f32x4*)(bgate + c0), ba1 = *(const GAS f32x4*)(bgate + c0 + 4), bb0 = *(const GAS f32x4*)(bgate + c0 + 128), bb1 = *(const GAS f32x4*)(bgate + c0 + 132);
            f32x4 r0, r1, r2, r3;
#pragma unroll
            for (int e = 0; e < 4; ++e) { r0[e] = sigmoidf_(a0[e] + ba0[e]); r1[e] = sigmoidf_(a1[e] + ba1[e]); r2[e] = sigmoidf_(b0[e] + bb0[e]); r3[e] = sigmoidf_(b1[e] + bb1[e]); }
            bf16* p = G + (size_t)row * 2048 + c0; *(GAS v4u*)p = pack8(r0, r1); *(GAS v4u*)(p + 128) = pack8(r2, r3);
        }
    }
};
struct FQup {
    bf16* Q; const float* SSQQ; const float* rtab;
    __device__ __forceinline__ void operator()(int row, int pn, int cb, f32x4 a0, f32x4 a1, f32x4 b0, f32x4 b1) const {
        const GAS f32x4* sp = (const GAS f32x4*)(SSQQ + (size_t)row * 8); const f32x4 s0 = sp[0], s1 = sp[1];
        const float ss = ((s0[0] + s0[1]) + (s0[2] + s0[3])) + ((s1[0] + s1[1]) + (s1[2] + s1[3]));
        const float sc = C2_MLA / sqrtf(ss * (1.0f / QR) + RMS_EPS);
        a0 = a0 * sc; a1 = a1 * sc; b0 = b0 * sc; b1 = b1 * sc;
        const float* tr = rtab + (size_t)(row & (SEQ - 1)) * 32;
        const int ca = 256 * pn + cb, cbb = ca + 128;
        { const int j = ca % 96; if (j >= 64) rope8(a0, a1, tr, (j - 64) >> 3); }
        { const int j = cbb % 96; if (j >= 64) rope8(b0, b1, tr, (j - 64) >> 3); }
        *(GAS v4u*)(Q + (size_t)row * 768 + ca) = pack8(a0, a1); *(GAS v4u*)(Q + (size_t)row * 768 + cbb) = pack8(b0, b1); asm volatile("" ::: "memory");
    }
};
struct FKVup {
    bf16* KV; const float* SSQKV;
    __device__ __forceinline__ void operator()(int row, int pn, int cb, f32x4 a0, f32x4 a1, f32x4 b0, f32x4 b1) const {
        const f32x4 s0 = *(const GAS f32x4*)(SSQKV + (size_t)row * 4);
        const float sc = 1.0f / sqrtf(((s0[0] + s0[1]) + (s0[2] + s0[3])) * (1.0f / KVR) + RMS_EPS);
        bf16* p = KV + (size_t)row * 1024 + 256 * pn + cb; *(GAS v4u*)p = pack8(a0 * sc, a1 * sc); *(GAS v4u*)(p + 128) = pack8(b0 * sc, b1 * sc);
    }
};
struct FYGate {
    bf16* MIX; const bf16* G;
    __device__ __forceinline__ void operator()(int row, int pn, int cb, f32x4 a0, f32x4 a1, f32x4 b0, f32x4 b1) const {
        const int c = 128 * pn + cb; f32x4 gm0, gm1, gd0, gd1;
        unpack8(*(const GAS v4u*)(G + (size_t)row * 2048 + c), gm0, gm1); unpack8(*(const GAS v4u*)(G + (size_t)row * 2048 + 1024 + c), gd0, gd1);
        *(GAS v4u*)(MIX + (size_t)row * D + c) = pack8(gm0 * a0 + gd0 * b0, gm1 * a1 + gd1 * b1);
    }
};

__device__ __forceinline__ int crow(int r, int hi) { return (r & 3) + 8 * (r >> 2) + 4 * hi; }
typedef short v4i16_t __attribute__((ext_vector_type(4)));
__device__ __forceinline__ s16x4 vtr(const LAS unsigned char* p) { return __builtin_bit_cast(s16x4, __builtin_amdgcn_ds_read_tr16_b64_v4i16((LAS v4i16_t*)p)); }
constexpr float NEGBIG = -1.0e30f;
constexpr int ATT_WSF_OFF = 53248, ATT_BIAS_OFF = 55296, BIAS_PITCH = 320;
template <int DQK, int DV, int KW1, bool CAUSAL, bool BIAS>
__device__ __forceinline__ void attn_core(LAS unsigned char* lds, const bf16* Qp, const bf16* K1, int ldk1, const bf16* K2, int ldk2, const bf16* V, int ldv,
                                          int NT, int qabs0, const LAS float* biasrow, f32x16 (&o)[DV / 32], int tid, int lane, int wave) {
    constexpr int KST = (DQK + 8) * 2, VST = (DV + 8) * 2, KCH = DQK / 8, VCH = DV / 8, NKS = DQK / 16, NCB = DV / 32;
    constexpr int KS_OFF = 0, VS_OFF = 64 * KST;
    static_assert(VS_OFF + 64 * VST <= ATT_WSF_OFF, "attention LDS map");
    const int r32 = lane & 31, hi = lane >> 5;
    bf16x8 qf[NKS];
#pragma unroll
    for (int ks = 0; ks < NKS; ++ks) qf[ks] = *(const GAS bf16x8*)(Qp + 16 * ks + 8 * hi);
#pragma unroll
    for (int cb = 0; cb < NCB; ++cb) o[cb] = f32x16{};
    float m = NEGBIG, l = 0.f;
    const LAS unsigned char* ka = lds + KS_OFF + r32 * KST + hi * 16;
    const LAS unsigned char* va = lds + VS_OFF + (4 * hi + ((lane & 15) >> 2)) * VST + (((lane >> 4) & 1) * 16 + (lane & 3) * 4) * 2;
    LAS float* wsf = (LAS float*)(lds + ATT_WSF_OFF) + wave * 64;
    const LAS float* wsr = wsf + 4 * hi;
    for (int t = 0; t < NT; ++t) {
        __syncthreads();
        for (int c = tid; c < 64 * KCH; c += NWAVES * 64) { const int row = c / KCH, ch = c - row * KCH; const int e0 = ch * 8;
            const bf16* src = (e0 < KW1) ? K1 + (size_t)(64 * t + row) * ldk1 + e0 : K2 + (size_t)(64 * t + row) * ldk2 + (e0 - KW1);
            *(LAS v4u*)(lds + KS_OFF + row * KST + e0 * 2) = *(const GAS v4u*)src; }
        for (int c = tid; c < 64 * VCH; c += NWAVES * 64) { const int row = c / VCH, ch = c - row * VCH;
            *(LAS v4u*)(lds + VS_OFF + row * VST + ch * 16) = *(const GAS v4u*)(V + (size_t)(64 * t + row) * ldv + ch * 8); }
        __syncthreads();
        if (CAUSAL && 64 * t > qabs0 + 31) continue;
        f32x16 p0 = f32x16{}, p1 = f32x16{};
#pragma unroll
        for (int ks = 0; ks < NKS; ++ks) {
            const bf16x8 a0 = *(const LAS bf16x8*)(ka + ks * 32), a1 = *(const LAS bf16x8*)(ka + 32 * KST + ks * 32);
            p0 = __builtin_amdgcn_mfma_f32_32x32x16_bf16(a0, qf[ks], p0, 0, 0, 0);
            p1 = __builtin_amdgcn_mfma_f32_32x32x16_bf16(a1, qf[ks], p1, 0, 0, 0);
        }
        const int qrel = qabs0 + r32 - 64 * t - 4 * hi;
        if (BIAS) { if (qabs0 - (64 * t + 63) < 128) {
            const LAS float* bp = biasrow + (qrel + 64 - 59);
#pragma unroll
            for (int r = 0; r < 16; ++r) { constexpr int dummy = 0; const int C = (r & 3) + 8 * (r >> 2); p0[r] += bp[59 - C + dummy]; p1[r] += bp[27 - C]; } } }
        if (CAUSAL) { if (64 * t + 63 > qabs0) {
#pragma unroll
            for (int r = 0; r < 16; ++r) { const int C = (r & 3) + 8 * (r >> 2); if (C > qrel) p0[r] = NEGBIG; if (C + 32 > qrel) p1[r] = NEGBIG; } } }
        float rm = p0[0];
#pragma unroll
        for (int r = 1; r < 16; ++r) rm = fmaxf(rm, p0[r]);
#pragma unroll
        for (int r = 0; r < 16; ++r) rm = fmaxf(rm, p1[r]);
        rm = fmaxf(rm, __shfl_xor(rm, 32));
        const float mn = fmaxf(m, rm), alpha = fexp2(m - mn); m = mn;
        if (hi == 0) wsf[r32] = alpha;
        float rs = 0.f;
#pragma unroll
        for (int r = 0; r < 16; ++r) { p0[r] = fexp2(p0[r] - mn); p1[r] = fexp2(p1[r] - mn); rs += p0[r] + p1[r]; }
        rs += __shfl_xor(rs, 32);
        l = l * alpha + rs;
#pragma unroll
        for (int r = 0; r < 16; ++r) { const float ar = wsr[(r & 3) + 8 * (r >> 2)];
#pragma unroll
            for (int cb = 0; cb < NCB; ++cb) o[cb][r] *= ar; }
        bf16x8 pa[4];
#pragma unroll
        for (int s = 0; s < 2; ++s) {
            v4u w0, w1;
            w0.x = cvtpk(p0[8 * s + 0], p0[8 * s + 1]); w0.y = cvtpk(p0[8 * s + 2], p0[8 * s + 3]); w0.z = cvtpk(p0[8 * s + 4], p0[8 * s + 5]); w0.w = cvtpk(p0[8 * s + 6], p0[8 * s + 7]);
            w1.x = cvtpk(p1[8 * s + 0], p1[8 * s + 1]); w1.y = cvtpk(p1[8 * s + 2], p1[8 * s + 3]); w1.z = cvtpk(p1[8 * s + 4], p1[8 * s + 5]); w1.w = cvtpk(p1[8 * s + 6], p1[8 * s + 7]);
            pa[s] = __builtin_bit_cast(bf16x8, w0); pa[2 + s] = __builtin_bit_cast(bf16x8, w1);
        }
#pragma unroll
        for (int cb = 0; cb < NCB; ++cb)
#pragma unroll
            for (int s = 0; s < 4; ++s) {
                const s16x4 lo = vtr(va + (16 * s) * VST + cb * 64), hh = vtr(va + (16 * s + 8) * VST + cb * 64);
                const bf16x8 vf = {lo[0], lo[1], lo[2], lo[3], hh[0], hh[1], hh[2], hh[3]};
                o[cb] = __builtin_amdgcn_mfma_f32_32x32x16_bf16(pa[s], vf, o[cb], 0, 0, 0);
            }
    }
    if (hi == 0) wsf[r32] = 1.0f / l;
#pragma unroll
    for (int r = 0; r < 16; ++r) { const float lr = wsr[(r & 3) + 8 * (r >> 2)];
#pragma unroll
        for (int cb = 0; cb < NCB; ++cb) o[cb][r] *= lr; }
}
template <int NCB> __device__ __forceinline__ void attn_store(bf16* Orow0, int ldo, const f32x16 (&o)[NCB], int lane) {
    const int r32 = lane & 31, hi = lane >> 5;
#pragma unroll
    for (int r = 0; r < 16; ++r)
#pragma unroll
        for (int cb = 0; cb < NCB; ++cb) Orow0[(size_t)crow(r, hi) * ldo + 32 * cb + r32] = (bf16)f2bf(o[cb][r]);
}

__device__ __forceinline__ void attn_phase_mixer(unsigned char* ws, float* out, const float* dng, LAS unsigned char* lds, int vcu, int G, int tid, int lane, int wave, const unsigned* zero_word) {
    { const float* bt = (const float*)(ws + WS_TAB + 256 * 1024); LAS float* lb = (LAS float*)(lds + ATT_BIAS_OFF);
      for (int i = tid; i < 8 * BIAS_PITCH; i += NWAVES * 64) { const int mp = i / BIAS_PITCH, n = i - mp * BIAS_PITCH - 64; lb[i] = (n >= 0 && n < 128) ? bt[mp * 128 + n] : 0.f; } }
    const float lam = ((const float*)(ws + WS_TAB + 260 * 1024))[0];
    __syncthreads();
    const bf16* QMLA = (const bf16*)((unsigned char*)out + OUT_QMLA); const bf16* KVMLA = (const bf16*)(ws + WS_HB); const bf16* KROPE = (const bf16*)(ws + WS_KROPE);
    const bf16* QD = (const bf16*)(ws + WS_QD); const bf16* KD = (const bf16*)(ws + WS_KD); const bf16* VD = (const bf16*)(ws + WS_VD);
    bf16* OMD = (bf16*)((unsigned char*)out + OUT_OMD);
    const int r32 = lane & 31, hi = lane >> 5;
    for (int i = 0; i < 2; ++i) {
        const int d = (i == 0) ? vcu : 511 - vcu; if (vcu >= 256) break;
        const int qb = 7 - (d >> 6), rem = d & 63; const int q0 = 256 * qb, NT = (q0 + 256) / 64, qabs0 = q0 + 32 * wave;
        {
            const int b = rem >> 2, h = rem & 3; const size_t rb = (size_t)b * SEQ, qrow = rb + qabs0 + r32;
            f32x16 o1[4]; unsigned o2p[4][8];
            attn_core<64, 128, 64, true, true>(lds, QD + qrow * 512 + 128 * h + 64, KD + rb * 512 + 128 * h + 64, 512, nullptr, 0, VD + rb * 512 + 128 * h, 512, NT, qabs0,
                                               (const LAS float*)(lds + ATT_BIAS_OFF) + BIAS_PITCH * (2 * h + 1), o1, tid, lane, wave);
#pragma unroll
            for (int cb = 0; cb < 4; ++cb)
#pragma unroll
                for (int r = 0; r < 8; ++r) o2p[cb][r] = cvtpk(o1[cb][2 * r], o1[cb][2 * r + 1]);
            attn_core<64, 128, 64, true, true>(lds, QD + qrow * 512 + 128 * h, KD + rb * 512 + 128 * h, 512, nullptr, 0, VD + rb * 512 + 128 * h, 512, NT, qabs0,
                                               (const LAS float*)(lds + ATT_BIAS_OFF) + BIAS_PITCH * (2 * h), o1, tid, lane, wave);
            float gg[4];
#pragma unroll
            for (int cb = 0; cb < 4; ++cb) gg[cb] = dng[32 * cb + r32] * (1.0f - LAM_INIT);
#pragma unroll
            for (int r = 0; r < 16; ++r) {
                float ss = 0.f;
#pragma unroll
                for (int cb = 0; cb < 4; ++cb) { const unsigned w = o2p[cb][r >> 1]; const float o2v = __builtin_bit_cast(float, (r & 1) ? (w & 0xffff0000u) : (w << 16));
                    o1[cb][r] -= lam * o2v; ss += o1[cb][r] * o1[cb][r]; }
                ss += __shfl_xor(ss, 1); ss += __shfl_xor(ss, 2); ss += __shfl_xor(ss, 4); ss += __shfl_xor(ss, 8); ss += __shfl_xor(ss, 16);
                const float rinv = 1.0f / sqrtf(ss * (1.0f / 128.0f) + RMS_EPS);
#pragma unroll
                for (int cb = 0; cb < 4; ++cb) o1[cb][r] *= rinv * gg[cb];
            }
            attn_store<4>(OMD + (rb + qabs0) * 1024 + 512 + 128 * h, 1024, o1, lane);
        }
    }
    __syncthreads();
    const int lane2 = (int)((threadIdx.x | *(volatile GAS unsigned*)zero_word) & 63u); const int r32b = lane2 & 31;
    for (int i = 0; i < 4; ++i) {
        const int d = (i & 1) ? 511 - vcu : vcu; if (vcu >= 256) break;
        const int qb = 7 - (d >> 6), rem = (d & 63) + 64 * (i >> 1); const int q0 = 256 * qb, NT = (q0 + 256) / 64, qabs0 = q0 + 32 * wave;
        {
            const int b = rem >> 3, h = rem & 7; const size_t rb = (size_t)b * SEQ, qrow = rb + qabs0 + r32b;
            f32x16 o[2];
            attn_core<96, 64, 64, true, false>(lds, QMLA + qrow * 768 + 96 * h, KVMLA + rb * 1024 + 64 * h, 1024, KROPE + rb * 32, 32, KVMLA + rb * 1024 + 512 + 64 * h, 1024, NT, qabs0,
                                               nullptr, o, tid, lane2, wave);
            attn_store<2>(OMD + (rb + qabs0) * 1024 + 64 * h, 1024, o, lane2);
        }
    }
}
__device__ __forceinline__ void attn_phase_mem(unsigned char* ws, LAS unsigned char* lds, int vcu, int G, int tid, int lane, int wave) {
    const bf16* QM = (const bf16*)(ws + WS_QM); const bf16* KVM = (const bf16*)(ws + WS_KVM); bf16* OMEM = (bf16*)(ws + WS_OMEM);
    const int r32 = lane & 31;
    constexpr int NU = BATCH * 4 * 8;
    for (int u = vcu; u < NU; u += G) {
        const int b = u >> 5, h = (u >> 3) & 3, qb = u & 7; const int qabs0 = 256 * qb + 32 * wave; const size_t rb = (size_t)b * SEQ, qrow = rb + qabs0 + r32, kb = (size_t)b * MEML;
#pragma unroll 1
        for (int half = 0; half < 2; ++half) {
            f32x16 o[4];
            attn_core<256, 128, 256, false, false>(lds, QM + qrow * 1024 + 256 * h, KVM + kb * 2048 + 256 * h, 2048, nullptr, 0, KVM + kb * 2048 + 1024 + 256 * h + 128 * half, 2048, MEML / 64, qabs0,
                                                   nullptr, o, tid, lane, wave);
            attn_store<4>(OMEM + (rb + qabs0) * 1024 + 256 * h + 128 * half, 1024, o, lane);
        }
    }
}

struct Args { const float* in[35]; float* out; unsigned char* ws; int ph_lo, ph_hi; };
__global__ void __launch_bounds__(NWAVES * 64, 2) mk_fwd(Args args) {
    extern __shared__ __attribute__((aligned(16))) unsigned char lds_raw[];
    LAS unsigned char* lds = (LAS unsigned char*)lds_raw;
    volatile LAS unsigned* MISC = (volatile LAS unsigned*)(lds + MISC_OFF);
    const int tid = threadIdx.x, lane = tid & 63, wave = __builtin_amdgcn_readfirstlane(tid >> 6);
    const int G = gridDim.x; const int bx = blockIdx.x; const int vcu = (G % 8 == 0) ? (bx % 8) * (G / 8) + bx / 8 : bx;
    unsigned char* ws = args.ws; float* out = args.out; const float* const* in = args.in;
    gu32* ctl = (gu32*)(ws + WS_CTL);
    for (int u = tid; u < (LDS_BYTES - LDSCTL_OFF) / 4; u += NWAVES * 64) ((LAS unsigned*)(lds + LDSCTL_OFF))[u] = 0u;
    __syncthreads();
    XcdBarrier bar; bar.bar = (unsigned*)(ctl + CW_BAR); bar.x = 0; bar.st = nullptr;
    if (MK_ONE_LAUNCH) bar = xcd_barrier_post((unsigned*)(ctl + CW_BAR), MISC + 8);
    const int lo = args.ph_lo, hi = args.ph_hi;
#ifndef PH_MASK
#define PH_MASK 0x1ffff
#endif
#define IN(k) ((((PH_MASK) >> (k)) & 1) && lo <= (k) && (k) < hi)
#define OPQ_STR2(x) #x
#define OPQ_STR(x) OPQ_STR2(x)
#define OPQ_TID() const int tid_ = tid; const int lane_ = (int)((threadIdx.x | *(volatile GAS unsigned*)(ctl + 8)) & 63u)
#define SEAM(k) do { if (IN(k) && IN((k) + 1)) xcd_barrier(bar); } while (0)
    const int gw = vcu * NWAVES + wave, NGW = G * NWAVES;
    float* HF = (float*)(ws + WS_HF); bf16* HB = (bf16*)(ws + WS_HB); bf16* U = (bf16*)(ws + WS_U);

    if (IN(PH_PRO)) { OPQ_TID(); p0_prologue(in, ws, lds, vcu, G, wave, lane_, tid_); }
    SEAM(PH_PRO);
    if (IN(PH_FFN1UP)) {
        { pg8::Gemm g{HB, (const bf16*)(ws + WS_W1C1), M, 2 * FF, D}; pg8::StaticOrder S; S.init(M, 2 * FF, G, bx); EpiRow<FSwiglu> E{{U}};
          pg8::gemm_phase<EpiRow<FSwiglu>, pg8::StaticOrder, true, true>(lds + RING_OFF, g, S, E, (const unsigned*)(ctl + 8)); }
        { pg8::Gemm g{(const bf16*)(ws + WS_MEMB), (const bf16*)(ws + WS_WMKV), MM, 2048, D}; pg8::StaticOrder S; S.init(MM, 2048, G, bx); EpiRow<FPlain> E{{(bf16*)(ws + WS_KVM), 2048, 1.0f}};
          pg8::gemm_phase<EpiRow<FPlain>, pg8::StaticOrder, true, true>(lds + RING_OFF, g, S, E, (const unsigned*)(ctl + 8)); }
    }
    SEAM(PH_FFN1UP);
    if (IN(PH_FFN1DN)) {
        pg8::Gemm g{U, (const bf16*)(ws + WS_W21), M, D, FF}; pg8::StaticOrder S; S.init(M, D, G, bx); EpiRow<FResid> E{{in[IN_X], out, 0.5f}};
        pg8::gemm_phase<EpiRow<FResid>, pg8::StaticOrder, true, true>(lds + RING_OFF, g, S, E, (const unsigned*)(ctl + 8));
    }
    SEAM(PH_FFN1DN);
    if (IN(PH_LN1)) { OPQ_TID(); ln_rows(out, in[IN_LN1G], in[IN_LN1B], HF, HB, gw, NGW, lane_); }
    SEAM(PH_LN1);
    if (IN(PH_PROJ)) {
        pg8::Gemm g{HB, (const bf16*)(ws + WS_WPG), M, NPG, D}; pg8::StaticOrder S; S.init(M, NPG, G, bx);
        EpiRow<FProj> E{{(bf16*)((unsigned char*)out + OUT_CQ), (bf16*)((unsigned char*)out + OUT_CKV), (bf16*)(ws + WS_KROPE), (bf16*)(ws + WS_QD), (bf16*)(ws + WS_G),
                         (float*)(ws + WS_SSQQ), (float*)(ws + WS_SSQKV), in[IN_BGATE], (const float*)(ws + WS_TAB)}};
        pg8::gemm_phase<EpiRow<FProj>, pg8::StaticOrder, true, true>(lds + RING_OFF, g, S, E, (const unsigned*)(ctl + 8));
    }
    SEAM(PH_PROJ);
    if (IN(PH_QKVUP)) {
#ifndef NO_QUP
        { pg8::Gemm g{(const bf16*)((unsigned char*)out + OUT_CQ), (const bf16*)(ws + WS_WQB), M, 768, QR}; pg8::StaticOrder S; S.init(M, 768, G, bx);
          EpiRow<FQup> E{{(bf16*)((unsigned char*)out + OUT_QMLA), (const float*)(ws + WS_SSQQ), (const float*)(ws + WS_TAB)}};
          pg8::gemm_phase<EpiRow<FQup>, pg8::StaticOrder, true, true>(lds + RING_OFF, g, S, E, (const unsigned*)(ctl + 8)); }
#endif
#ifndef NO_KVUP
        { pg8::Gemm g{(const bf16*)((unsigned char*)out + OUT_CKV), (const bf16*)(ws + WS_WKVB), M, 1024, KVR}; pg8::StaticOrder S; S.init(M, 1024, G, bx);
          EpiRow<FKVup> E{{HB, (const float*)(ws + WS_SSQKV)}};
          pg8::gemm_phase<EpiRow<FKVup>, pg8::StaticOrder, true, true>(lds + RING_OFF, g, S, E, (const unsigned*)(ctl + 8)); }
#endif
    }
    SEAM(PH_QKVUP);
    if (IN(PH_ATTN)) { OPQ_TID(); attn_phase_mixer(ws, out, in[IN_DNG], lds, vcu, G, tid_, lane_, wave, (const unsigned*)(ctl + 8)); }
    SEAM(PH_ATTN);
    if (IN(PH_YG)) {
        pg8::Gemm g{(const bf16*)((unsigned char*)out + OUT_OMD), (const bf16*)(ws + WS_WY), M, 2048, D}; pg8::StaticOrder S; S.init(M, 2048, G, bx); EpiRow<FYGate> E{{HB, (const bf16*)(ws + WS_G)}};
        pg8::gemm_phase<EpiRow<FYGate>, pg8::StaticOrder, true, true>(lds + RING_OFF, g, S, E, (const unsigned*)(ctl + 8));
    }
    SEAM(PH_YG);
    if (IN(PH_WO)) {
        pg8::Gemm g{HB, (const bf16*)(ws + WS_WO), M, D, D}; pg8::StaticOrder S; S.init(M, D, G, bx); EpiRow<FResid> E{{HF, out, 1.0f}};
        pg8::gemm_phase<EpiRow<FResid>, pg8::StaticOrder, true, true>(lds + RING_OFF, g, S, E, (const unsigned*)(ctl + 8));
    }
    SEAM(PH_WO);
    if (IN(PH_LN2)) { OPQ_TID(); ln_rows(out, in[IN_LN2G], in[IN_LN2B], HF, HB, gw, NGW, lane_); }
    SEAM(PH_LN2);
    if (IN(PH_MEMQ)) {
        pg8::Gemm g{HB, (const bf16*)(ws + WS_WMQ), M, D, D}; pg8::StaticOrder S; S.init(M, D, G, bx); EpiRow<FPlain> E{{(bf16*)(ws + WS_QM), D, C2_MEM}};
        pg8::gemm_phase<EpiRow<FPlain>, pg8::StaticOrder, true, true>(lds + RING_OFF, g, S, E, (const unsigned*)(ctl + 8));
    }
    SEAM(PH_MEMQ);
    if (IN(PH_MEMATT)) { OPQ_TID(); attn_phase_mem(ws, lds, vcu, G, tid_, lane_, wave); }
    SEAM(PH_MEMATT);
    if (IN(PH_MEMO)) {
        pg8::Gemm g{(const bf16*)(ws + WS_OMEM), (const bf16*)(ws + WS_WMO), M, D, D}; pg8::StaticOrder S; S.init(M, D, G, bx); EpiRow<FResid> E{{HF, out, 1.0f}};
        pg8::gemm_phase<EpiRow<FResid>, pg8::StaticOrder, true, true>(lds + RING_OFF, g, S, E, (const unsigned*)(ctl + 8));
    }
    SEAM(PH_MEMO);
    if (IN(PH_LN3)) { OPQ_TID(); ln_rows(out, in[IN_LN3G], in[IN_LN3B], HF, HB, gw, NGW, lane_); }
    SEAM(PH_LN3);
    if (IN(PH_FFN2UP)) {
        pg8::Gemm g{HB, (const bf16*)(ws + WS_W1C2), M, 2 * FF, D}; pg8::StaticOrder S; S.init(M, 2 * FF, G, bx); EpiRow<FSwiglu> E{{U}};
        pg8::gemm_phase<EpiRow<FSwiglu>, pg8::StaticOrder, true, true>(lds + RING_OFF, g, S, E, (const unsigned*)(ctl + 8));
    }
    SEAM(PH_FFN2UP);
    if (IN(PH_FFN2DN)) {
        pg8::Gemm g{U, (const bf16*)(ws + WS_W22), M, D, FF}; pg8::StaticOrder S; S.init(M, D, G, bx); EpiRow<FResid> E{{HF, out, 0.5f}};
        pg8::gemm_phase<EpiRow<FResid>, pg8::StaticOrder, true, true>(lds + RING_OFF, g, S, E, (const unsigned*)(ctl + 8));
    }
    SEAM(PH_FFN2DN);
    if (IN(PH_LN4)) { OPQ_TID(); ln_rows(out, in[IN_LN4G], in[IN_LN4B], out, nullptr, gw, NGW, lane_); }
#undef IN
#undef SEAM
}

extern "C" void kernel_launch(void* const* d_in, const int* in_sizes, int n_in, void* d_out, int out_size, void* d_ws, size_t ws_size, hipStream_t stream) {
    static int grid = 0;
    if (grid == 0) {
        if (n_in != 35 || in_sizes[0] != M * D || out_size != M * D || ws_size < WS_END) { fprintf(stderr, "kernel_launch: unexpected shapes (n_in %d, in0 %d, out %d, ws %zu); nothing launched\n", n_in, n_in > 0 ? in_sizes[0] : -1, out_size, ws_size); grid = -1; return; }
        int dev = 0, cus = 0, per_cu = 0;
        if (hipGetDevice(&dev) != hipSuccess || hipDeviceGetAttribute(&cus, hipDeviceAttributeMultiprocessorCount, dev) != hipSuccess) { grid = -1; return; }
        if (hipFuncSetAttribute((const void*)mk_fwd, hipFuncAttributeMaxDynamicSharedMemorySize, LDS_BYTES) != hipSuccess) { fprintf(stderr, "kernel_launch: hipFuncSetAttribute failed\n"); grid = -1; return; }
        if (hipOccupancyMaxActiveBlocksPerMultiprocessor(&per_cu, (const void*)mk_fwd, NWAVES * 64, LDS_BYTES) != hipSuccess || per_cu < 1) { fprintf(stderr, "kernel_launch: occupancy query says %d blocks per CU\n", per_cu); per_cu = 1; }
        (void)hipGetLastError();
        grid = cus;
    }
    if (grid < 0) return;
    if (hipMemsetAsync((char*)d_ws + WS_CTL, 0, CTL_ZERO_BYTES, stream) != hipSuccess) { fprintf(stderr, "kernel_launch: hipMemsetAsync failed\n"); return; }
    Args a{};
    for (int i = 0; i < 35; ++i) a.in[i] = (const float*)d_in[i];
    a.out = (float*)d_out; a.ws = (unsigned char*)d_ws;
#if MK_ONE_LAUNCH
    a.ph_lo = 0; a.ph_hi = NPHASE;
    hipLaunchKernelGGL(mk_fwd, dim3(grid), dim3(NWAVES * 64), LDS_BYTES, stream, a);
#else
    for (int p = 0; p < NPHASE; ++p) { a.ph_lo = p; a.ph_hi = p + 1; hipLaunchKernelGGL(mk_fwd, dim3(grid), dim3(NWAVES * 64), LDS_BYTES, stream, a); }
#endif
}
```

```cpp
#include <hip/hip_runtime.h>
#include <cstdio>
#include <cstdint>
namespace pg8 {
#define PG8_LAS __attribute__((address_space(3)))
typedef unsigned short bf16_t;
typedef short bf16x8 __attribute__((ext_vector_type(8)));
typedef float f32x4 __attribute__((ext_vector_type(4)));
typedef unsigned u32x4 __attribute__((ext_vector_type(4)));
constexpr int BM = 256, BK = 64, HALF = 128, HTB = HALF * BK * 2  , STAGE_BYTES = 8 * HTB, NXCD = 8, WGM = 8;

__host__ __device__ __forceinline__ int lds_byte(int r, int c) { const int st = (r >> 4) * 2 + (c >> 5), rr = r & 15, cc = c & 31, ob = rr * 64 + cc * 2; return st * 1024 + (ob ^ (((ob >> 9) & 1) << 5)); }
__host__ __device__ __forceinline__ void stage_rc(int b, int& R, int& C) { const int st = b / 1024, sb = b % 1024, swz = sb ^ (((sb >> 9) & 1) << 5); R = (st >> 1) * 16 + swz / 64; C = (st & 1) * 32 + (swz % 64) / 2; }
__host__ __device__ __forceinline__ int perm32(int rho) { const int n = rho >> 4, i = rho & 15; return 8 * (i >> 2) + 4 * n + (i & 3); }

struct Unit { int pm, pn; };
struct Gemm { const bf16_t* A; const bf16_t* Bt; int M, N, K; };

struct StaticOrder {
    int nM, nN, nwg, G, c;
    __host__ __device__ void init(int M, int N, int G_, int c_) { nM = M / BM; nN = N / BM; nwg = nM * nN; G = G_; c = c_; }
    __host__ __device__ bool next(int i, Unit& u) const {
        const long L = (long)i * G + c; if (L >= nwg) return false;
        int wgid = (int)L; { const int q = nwg / NXCD, r = nwg % NXCD, xcd = wgid % NXCD, off = wgid / NXCD; wgid = (xcd < r ? xcd * (q + 1) : r * (q + 1) + (xcd - r) * q) + off; }
        const int nig = WGM * nN, gid = wgid / nig, fm = gid * WGM, gsz = (nM - fm) < WGM ? (nM - fm) : WGM;
        u.pm = fm + ((wgid % nig) % gsz); u.pn = (wgid % nig) / gsz; return true;
    }
    __device__ __forceinline__ void a_ready(const Unit&) const {}
    __device__ __forceinline__ void done(const Unit&) const {}
};

__device__ __forceinline__ unsigned cvt_pk_bf16(float lo, float hi) { unsigned r; asm volatile("v_cvt_pk_bf16_f32 %0, %1, %2" : "=v"(r) : "v"(lo), "v"(hi)); return r; }
template <class Epi, class Sched, bool ALIGN_EPI = false, bool SP2 = false>
__device__ __forceinline__ void gemm_phase(PG8_LAS unsigned char* lds, const Gemm g, const Sched& S, const Epi& E, const unsigned* zero_word) {
    int tid_ = (int)(threadIdx.x | *(volatile __attribute__((address_space(1))) unsigned*)zero_word);
    const int tid = tid_, wid = __builtin_amdgcn_readfirstlane(tid >> 6), lane = tid & 63, wr = wid >> 2, wc = wid & 3, fr = lane & 15, fq = lane >> 4;
    const int K = g.K, nt = K / BK;
    unsigned voffA[2], voffB[2];
#pragma unroll
    for (int i = 0; i < 2; ++i) { int R, C; stage_rc(tid * 16 + i * 8192, R, C); const int Rb = Epi::PERM ? ((R & ~31) + perm32(R & 31)) : R;
        voffA[i] = (unsigned)(R * K + C) * 2u; voffB[i] = (unsigned)(Rb * K + C) * 2u; }
    const size_t kstep = (size_t)(BK * 2);
    const size_t hstep = (size_t)HALF * K * 2;
    const size_t tstep = 2 * hstep;
    const unsigned ldsw = (unsigned)wid * 1024u;
    const int aoff = lds_byte(wr * 64 + fr, fq * 8), boff = lds_byte(wc * 32 + fr, fq * 8);
#define PG8_SA(b, h) (((b) * 2 + (h)) * HTB)
#define PG8_SB(b, h) ((4 + (b) * 2 + (h)) * HTB)
#define PG8_STAGE(bufoff, gbase, voff) do { _Pragma("unroll") for (int _i = 0; _i < 2; ++_i) \
        __builtin_amdgcn_global_load_lds((const unsigned*)((const char*)(gbase) + (voff)[_i]), (PG8_LAS unsigned*)(lds + (bufoff) + ldsw + _i * 8192), 16, 0, 0); } while (0)
#define PG8_LDA(dst, b, h) do { _Pragma("unroll") for (int m = 0; m < 4; ++m) _Pragma("unroll") for (int k = 0; k < 2; ++k) dst[m][k] = *(const PG8_LAS bf16x8*)(lds + PG8_SA(b, h) + aoff + m * 2048 + k * 1024); } while (0)
#define PG8_LDB(dst, b, h) do { _Pragma("unroll") for (int n = 0; n < 2; ++n) _Pragma("unroll") for (int k = 0; k < 2; ++k) dst[n][k] = *(const PG8_LAS bf16x8*)(lds + PG8_SB(b, h) + boff + n * 2048 + k * 1024); } while (0)
#define PG8_MMA(ai, bj, At, Bt) do { __builtin_amdgcn_s_setprio(1); _Pragma("unroll") for (int m = 0; m < 4; ++m) _Pragma("unroll") for (int n = 0; n < 2; ++n) _Pragma("unroll") for (int k = 0; k < 2; ++k) \
        acc[ai][bj][m][n] = __builtin_amdgcn_mfma_f32_16x16x32_bf16(Bt[n][k], At[m][k], acc[ai][bj][m][n], 0, 0, 0); __builtin_amdgcn_s_setprio(0); } while (0)
#define PG8_WAIT_V(n) asm volatile("s_waitcnt vmcnt(" #n ")" ::: "memory")
#define PG8_WAIT_L(n) asm volatile("s_waitcnt lgkmcnt(" #n ")" ::: "memory")
#define PG8_BAR __builtin_amdgcn_s_barrier()
#define PG8_SCHED __builtin_amdgcn_sched_barrier(0)
    Unit cur, nxt; int ui = 0;
    if (!S.next(0, cur)) return;
    f32x4 acc[2][2][4][2];
#pragma unroll
    for (int a = 0; a < 2; ++a)
#pragma unroll
        for (int b = 0; b < 2; ++b)
#pragma unroll
            for (int m = 0; m < 4; ++m)
#pragma unroll
                for (int n = 0; n < 2; ++n) acc[a][b][m][n] = (f32x4){0.f, 0.f, 0.f, 0.f};
    bf16x8 At[4][2], B0[2][2], B1[2][2];
    const char* cA = (const char*)g.A + (size_t)cur.pm * tstep; const char* cB = (const char*)g.Bt + (size_t)cur.pn * tstep;
    S.a_ready(cur);
    if constexpr (SP2) {
        PG8_STAGE(PG8_SB(0, 0), cB, voffB); PG8_STAGE(PG8_SB(0, 1), cB + hstep, voffB); PG8_STAGE(PG8_SA(0, 0), cA, voffA); PG8_STAGE(PG8_SA(0, 1), cA + hstep, voffA);
        if (wr == 1) PG8_BAR;
        PG8_WAIT_V(2); PG8_BAR;
        PG8_STAGE(PG8_SB(1, 0), cB + kstep, voffB); PG8_STAGE(PG8_SA(1, 0), cA + kstep, voffA); PG8_STAGE(PG8_SB(1, 1), cB + hstep + kstep, voffB);
        PG8_WAIT_V(6); PG8_BAR;
    } else {
        PG8_STAGE(PG8_SB(0, 0), cB, voffB); PG8_STAGE(PG8_SA(0, 0), cA, voffA); PG8_STAGE(PG8_SB(0, 1), cB + hstep, voffB); PG8_STAGE(PG8_SA(0, 1), cA + hstep, voffA);
        if (wr == 1) PG8_BAR;
        PG8_WAIT_V(4); PG8_BAR;
        PG8_STAGE(PG8_SB(1, 0), cB + kstep, voffB); PG8_STAGE(PG8_SA(1, 0), cA + kstep, voffA); PG8_STAGE(PG8_SB(1, 1), cB + hstep + kstep, voffB);
        PG8_WAIT_V(6); PG8_BAR;
    }
    for (;;) {
        const bool has_next = S.next(ui + 1, nxt);
        const char* nA = has_next ? (const char*)g.A + (size_t)nxt.pm * tstep : cA; const char* nB = has_next ? (const char*)g.Bt + (size_t)nxt.pn * tstep : cB;
_Pragma("nounroll")
        for (int t = 0; t < nt; t += 2) {
            const bool last = (t == nt - 2);
            const char* a1 = cA + (size_t)(t + 1) * kstep;
            const char* a2 = last ? nA : cA + (size_t)(t + 2) * kstep; const char* b2 = last ? nB : cB + (size_t)(t + 2) * kstep;
            const char* a3 = a2 + kstep; const char* b3 = b2 + kstep;
            if (last && has_next) S.a_ready(nxt);
            if constexpr (SP2) {
            PG8_LDB(B0, 0, 0); PG8_LDB(B1, 0, 1); PG8_SCHED; PG8_LDA(At, 0, 0); PG8_STAGE(PG8_SA(1, 1), a1 + hstep, voffA);
            PG8_WAIT_V(8); PG8_WAIT_L(0); PG8_BAR; PG8_MMA(0, 0, At, B0); PG8_MMA(0, 1, At, B1); PG8_BAR; PG8_SCHED;
            PG8_LDA(At, 0, 1); PG8_STAGE(PG8_SB(0, 0), b2, voffB); PG8_STAGE(PG8_SB(0, 1), b2 + hstep, voffB); PG8_STAGE(PG8_SA(0, 0), a2, voffA);
            PG8_WAIT_V(8); PG8_WAIT_L(0); PG8_BAR; PG8_MMA(1, 0, At, B0); PG8_MMA(1, 1, At, B1); PG8_BAR; PG8_SCHED;
            PG8_LDB(B0, 1, 0); PG8_LDB(B1, 1, 1); PG8_SCHED; PG8_LDA(At, 1, 0); PG8_STAGE(PG8_SA(0, 1), a2 + hstep, voffA);
            PG8_WAIT_V(8); PG8_WAIT_L(0); PG8_BAR; PG8_MMA(0, 0, At, B0); PG8_MMA(0, 1, At, B1); PG8_BAR; PG8_SCHED;
            PG8_LDA(At, 1, 1); PG8_STAGE(PG8_SB(1, 0), b3, voffB); PG8_STAGE(PG8_SB(1, 1), b3 + hstep, voffB); PG8_STAGE(PG8_SA(1, 0), a3, voffA);
            PG8_WAIT_V(8); PG8_WAIT_L(0); PG8_BAR; PG8_MMA(1, 0, At, B0); PG8_MMA(1, 1, At, B1); PG8_BAR; PG8_SCHED;
            } else {
            PG8_LDB(B0, 0, 0); PG8_SCHED; PG8_LDA(At, 0, 0); PG8_STAGE(PG8_SA(1, 1), a1 + hstep, voffA);
            PG8_WAIT_L(8); PG8_BAR; PG8_WAIT_L(0); PG8_MMA(0, 0, At, B0); PG8_BAR; PG8_SCHED;
            PG8_LDB(B1, 0, 1); PG8_STAGE(PG8_SB(0, 0), b2, voffB);
            PG8_BAR; PG8_WAIT_L(0); PG8_MMA(0, 1, At, B1); PG8_BAR;
            PG8_LDA(At, 0, 1); PG8_STAGE(PG8_SA(0, 0), a2, voffA);
            PG8_BAR; PG8_WAIT_L(0); PG8_MMA(1, 0, At, B0); PG8_BAR; PG8_SCHED;
            PG8_STAGE(PG8_SB(0, 1), b2 + hstep, voffB);
            PG8_WAIT_V(6); PG8_BAR; PG8_MMA(1, 1, At, B1); PG8_BAR;
            PG8_LDB(B0, 1, 0); PG8_SCHED; PG8_LDA(At, 1, 0); PG8_STAGE(PG8_SA(0, 1), a2 + hstep, voffA);
            PG8_WAIT_L(8); PG8_BAR; PG8_WAIT_L(0); PG8_MMA(0, 0, At, B0); PG8_BAR; PG8_SCHED;
            PG8_LDB(B1, 1, 1); PG8_STAGE(PG8_SB(1, 0), b3, voffB);
            PG8_BAR; PG8_WAIT_L(0); PG8_MMA(0, 1, At, B1); PG8_BAR;
            PG8_LDA(At, 1, 1); PG8_STAGE(PG8_SA(1, 0), a3, voffA);
            PG8_BAR; PG8_WAIT_L(0); PG8_MMA(1, 0, At, B0); PG8_BAR; PG8_SCHED;
            PG8_STAGE(PG8_SB(1, 1), b3 + hstep, voffB);
            PG8_WAIT_V(6); PG8_BAR; PG8_MMA(1, 1, At, B1); PG8_BAR;
            }
        }
        if constexpr (ALIGN_EPI) { if (wr == 0) PG8_BAR; }
        if constexpr (!Epi::AFTER_DRAIN) { E(acc, cur, wr, wc, fr, fq); S.done(cur); }
        if (!has_next) break;
#pragma unroll
        for (int a = 0; a < 2; ++a)
#pragma unroll
            for (int b = 0; b < 2; ++b)
#pragma unroll
                for (int m = 0; m < 4; ++m)
#pragma unroll
                    for (int n = 0; n < 2; ++n) acc[a][b][m][n] = (f32x4){0.f, 0.f, 0.f, 0.f};
        cur = nxt; cA = nA; cB = nB; ++ui;
        if constexpr (ALIGN_EPI) { if (wr == 1) PG8_BAR; }
    }
    PG8_WAIT_V(0);
    if constexpr (!ALIGN_EPI) { if (wr == 0) PG8_BAR; }
    PG8_BAR;
    if constexpr (Epi::AFTER_DRAIN) { E.fused(acc, cur, wr, wc, fr, fq, lds, wid, lane); S.done(cur); }
#undef PG8_SA
#undef PG8_SB
#undef PG8_STAGE
#undef PG8_LDA
#undef PG8_LDB
#undef PG8_MMA
#undef PG8_WAIT_V
#undef PG8_WAIT_L
#undef PG8_BAR
#undef PG8_SCHED
}
}

template <class F> struct EpiRow {
    static constexpr bool PERM = true, AFTER_DRAIN = false;
    F f;
    __device__ __forceinline__ void operator()(const pg8::f32x4 (&acc)[2][2][4][2], const pg8::Unit& u, int wr, int wc, int fr, int fq) const {
        const int rowb = u.pm * 256 + wr * 64 + fr, cb = wc * 32 + 8 * fq;
#pragma unroll
        for (int ai = 0; ai < 2; ++ai)
#pragma unroll
            for (int m = 0; m < 4; ++m) { f(rowb + ai * 128 + m * 16, u.pn, cb, acc[ai][0][m][0], acc[ai][0][m][1], acc[ai][1][m][0], acc[ai][1][m][1]); if (m & 1) asm volatile("" ::: "memory"); }
    }
};

#define GAS __attribute__((address_space(1)))
#define LAS __attribute__((address_space(3)))
typedef unsigned short bf16;
typedef unsigned v4u __attribute__((ext_vector_type(4)));
typedef unsigned v2u __attribute__((ext_vector_type(2)));
typedef float f32x4 __attribute__((ext_vector_type(4)));
typedef float f32x16 __attribute__((ext_vector_type(16)));
typedef short bf16x8 __attribute__((ext_vector_type(8)));
typedef short s16x4 __attribute__((ext_vector_type(4)));
typedef GAS unsigned gu32;
typedef GAS unsigned long long gu64;
#define RLX_AGENT __ATOMIC_RELAXED, __HIP_MEMORY_SCOPE_AGENT
#define LDS_WAIT() asm volatile("s_waitcnt lgkmcnt(0)" ::: "memory")
#define VM_WAIT() asm volatile("s_waitcnt vmcnt(0)" ::: "memory")
__device__ __forceinline__ unsigned f2bf(float f) { unsigned u = __builtin_bit_cast(unsigned, f); return (u + 0x7fffu + ((u >> 16) & 1u)) >> 16; }
__device__ __forceinline__ unsigned pk2(float lo, float hi) { return f2bf(lo) | (f2bf(hi) << 16); }
__device__ __forceinline__ float bf2f(unsigned short b) { return __builtin_bit_cast(float, (unsigned)b << 16); }
__device__ __forceinline__ unsigned cvtpk(float lo, float hi) { return pg8::cvt_pk_bf16(lo, hi); }
__device__ __forceinline__ v4u pack8(f32x4 a, f32x4 b) { v4u w; w.x = cvtpk(a[0], a[1]); w.y = cvtpk(a[2], a[3]); w.z = cvtpk(b[0], b[1]); w.w = cvtpk(b[2], b[3]); return w; }
__device__ __forceinline__ void unpack8(v4u w, f32x4& a, f32x4& b) {
    a[0] = __builtin_bit_cast(float, w.x << 16); a[1] = __builtin_bit_cast(float, w.x & 0xffff0000u); a[2] = __builtin_bit_cast(float, w.y << 16); a[3] = __builtin_bit_cast(float, w.y & 0xffff0000u);
    b[0] = __builtin_bit_cast(float, w.z << 16); b[1] = __builtin_bit_cast(float, w.z & 0xffff0000u); b[2] = __builtin_bit_cast(float, w.w << 16); b[3] = __builtin_bit_cast(float, w.w & 0xffff0000u); }
__device__ __forceinline__ float fexp2(float x) { return __builtin_amdgcn_exp2f(x); }
__device__ __forceinline__ float frcp(float x) { return __builtin_amdgcn_rcpf(x); }
__device__ __forceinline__ float sigmoidf_(float x) { return frcp(1.0f + fexp2(-1.4426950408889634f * x)); }
#define XB_TMO      128
#define XB_XCNT(j)  (256  + 64 * (j))
#define XB_XSUB(j)  (1280 + 64 * (j))
#define XB_XGEN(j)  (2304 + 64 * (j))
#define XB_TOP      3328
#define XB_TOPGEN   3392
#define XCD_BAR_WORDS 3456
#define XB_SPIN_CAP (1u << 18)

__device__ __forceinline__ unsigned xb_ld(unsigned* p)              { return __hip_atomic_load(p, __ATOMIC_RELAXED, __HIP_MEMORY_SCOPE_AGENT); }
__device__ __forceinline__ unsigned xb_add(unsigned* p, unsigned v) { return __hip_atomic_fetch_add(p, v, __ATOMIC_RELAXED, __HIP_MEMORY_SCOPE_AGENT); }
__device__ __forceinline__ unsigned xb_xcc_id() { return (unsigned)__builtin_amdgcn_s_getreg((3 << 11) | 20) & 0xFu; }
#define XB_SPIN(cond, bar) do { unsigned _sp = 0; while (cond) { __builtin_amdgcn_s_sleep(1); \
    if ((++_sp & 255u) == 0u) { if (xb_ld(&(bar)[XB_TMO])) break; if (_sp > XB_SPIN_CAP) { atomicAdd(&(bar)[XB_TMO], 1u); break; } } } } while (0)

struct XcdBarrier {
    unsigned* bar; unsigned x;
    volatile LAS unsigned* st;
};

__device__ __forceinline__ XcdBarrier xcd_barrier_post(unsigned* bar, volatile LAS unsigned* st) {
    XcdBarrier b; b.bar = bar; b.x = xb_xcc_id(); b.st = st;
    if (threadIdx.x == 0) (void)xb_add(&bar[XB_XCNT(b.x)], 1u);
    return b;
}
__device__ __forceinline__ void xcd_barrier_complete(unsigned* bar, unsigned x, unsigned& nloc, unsigned& nx) {
    const unsigned G = gridDim.x * gridDim.y * gridDim.z;
    unsigned sum, cnt, mine, sp = 0u;
    for (;;) {
        sum = 0u; cnt = 0u; mine = 0u;
#pragma unroll
        for (unsigned j = 0; j < 16; ++j) { const unsigned c = xb_ld(&bar[XB_XCNT(j)]); sum += c; cnt += (c > 0u) ? 1u : 0u; mine = (j == x) ? c : mine; }
        if (sum == G) break;
        __builtin_amdgcn_s_sleep(1);
        if ((++sp & 255u) == 0u) { if (xb_ld(&bar[XB_TMO])) break; if (sp > XB_SPIN_CAP) { atomicAdd(&bar[XB_TMO], 1u); break; } }
    }
    nloc = mine > 0u ? mine : 1u; nx = cnt > 0u ? cnt : 1u;
}

__device__ __forceinline__ void xcd_barrier(const XcdBarrier& b) {
    asm volatile("s_waitcnt vmcnt(0)" ::: "memory");
    __syncthreads();
    if (threadIdx.x == 0) {
        unsigned* bar = b.bar;
        __builtin_amdgcn_s_waitcnt(0);
        unsigned nloc = b.st[0], nx = b.st[1];
        if (nloc == 0u) { xcd_barrier_complete(bar, b.x, nloc, nx); b.st[0] = nloc; b.st[1] = nx; }
        const unsigned old = xb_add(&bar[XB_XSUB(b.x)], 1u);
        const unsigned gen = old / nloc;
        if (old + 1u == (gen + 1u) * nloc) {
            __builtin_amdgcn_fence(__ATOMIC_RELEASE, "agent");
            asm volatile("s_waitcnt vmcnt(0)" ::: "memory");
            const unsigned og = xb_add(&bar[XB_TOP], 1u);
            const unsigned tg = og / nx;
            if (og + 1u == (tg + 1u) * nx) xb_add(&bar[XB_TOPGEN], 1u);
            else XB_SPIN(xb_ld(&bar[XB_TOPGEN]) == tg, bar);
            __builtin_amdgcn_fence(__ATOMIC_ACQUIRE, "agent");
            xb_add(&bar[XB_XGEN(b.x)], 1u);
            asm volatile("s_waitcnt vmcnt(0)" ::: "memory");
        } else {
            XB_SPIN(xb_ld(&bar[XB_XGEN(b.x)]) == gen, bar);
            __builtin_amdgcn_fence(__ATOMIC_ACQUIRE, "agent");
            asm volatile("s_waitcnt vmcnt(0)" ::: "memory");
        }
    }
    __syncthreads();
}

constexpr int NWAVES = 8;
#ifndef MK_ONE_LAUNCH
#define MK_ONE_LAUNCH 1
#endif
constexpr int BATCH = 16, SEQ = 2048, D = 1024, M = BATCH * SEQ, FF = 2816, MEML = 256, MM = BATCH * MEML;
constexpr int NPROJ = 2304, NPG = NPROJ + 2048;
constexpr int QR = 384, KVR = 256;
constexpr float LN_EPS = 1e-5f, RMS_EPS = 1e-6f;
constexpr float ALPHA = 1.189207115002721f;
constexpr float LOG2E = 1.4426950408889634f;
constexpr float C2_MLA = 0.10206207261596577f * LOG2E;
constexpr float C2_DIFF = 0.125f * LOG2E;
constexpr float C2_MEM = 0.0625f * LOG2E;
constexpr float LAM_INIT = 0.2f;
constexpr int NPHASE = 17;
enum { PH_PRO = 0, PH_FFN1UP, PH_FFN1DN, PH_LN1, PH_PROJ, PH_QKVUP, PH_ATTN, PH_YG, PH_WO, PH_LN2, PH_MEMQ, PH_MEMATT, PH_MEMO, PH_LN3, PH_FFN2UP, PH_FFN2DN, PH_LN4 };

constexpr size_t MiB = 1u << 20;
constexpr size_t WS_CTL = 0, CTL_ZERO_BYTES = 1 * MiB;
constexpr size_t WS_W1C1 = 1 * MiB, WS_W21 = 12 * MiB, WS_W1C2 = 18 * MiB, WS_W22 = 29 * MiB, WS_WPG = 35 * MiB, WS_WQB = 44 * MiB, WS_WKVB = 45 * MiB, WS_WY = 46 * MiB,
                 WS_WO = 50 * MiB, WS_WMQ = 52 * MiB, WS_WMKV = 54 * MiB, WS_WMO = 58 * MiB;
constexpr size_t WS_TAB = 60 * MiB;
constexpr size_t WS_SSQQ = 61 * MiB, WS_SSQKV = 62 * MiB;
constexpr size_t WS_KVM = 63 * MiB;
constexpr size_t WS_HF = 80 * MiB;
constexpr size_t WS_HB = 208 * MiB;
constexpr size_t WS_U = 272 * MiB;
constexpr size_t WS_G = 272 * MiB, WS_QM = 272 * MiB, WS_OMEM = 336 * MiB;
constexpr size_t WS_QD = 400 * MiB, WS_KD = 432 * MiB, WS_VD = 464 * MiB;
constexpr size_t WS_KROPE = 496 * MiB, WS_MEMB = 498 * MiB, WS_END = 512 * MiB;
constexpr size_t OUT_CQ = 0, OUT_CKV = 24 * MiB, OUT_QMLA = 80 * MiB, OUT_OMD = 0;
constexpr int CW_BAR = 4096;

constexpr int RING_OFF = 0, RING_BYTES = 131072;
constexpr int LDSCTL_OFF = RING_BYTES, MISC_OFF = LDSCTL_OFF + 320;
constexpr int LDS_BYTES = 147456;

__device__ __forceinline__ float wave_sum(float v) {
#pragma unroll
    for (int o = 1; o < 64; o <<= 1) v += __shfl_xor(v, o);
    return v;
}

__device__ __forceinline__ int ropepos(int i) { return i < 16 ? 8 * (i >> 2) + (i & 3) : 8 * ((i - 16) >> 2) + 4 + (i & 3); }
template <int MODE> __device__ __forceinline__ int rowmap(int n) {
    if constexpr (MODE == 0) return n;
    else if constexpr (MODE == 1) return 256 * (n >> 7) + (n & 127);
    else if constexpr (MODE == 2) return 256 * (n >> 7) + 128 + (n & 127);
    else if constexpr (MODE == 3) {
        if (n < 384) return n; if (n < 640) return 512 + (n - 384); if (n < 672) return 384 + ropepos(n - 640);
        if (n < 1184) return 768 + (n - 672); if (n < 1696) return 1280 + (n - 1184); return 1792 + (n - 1696); }
    else if constexpr (MODE == 4) return NPROJ + n;
    else if constexpr (MODE == 5) { const int h = n / 96, j = n - 96 * h; return j < 64 ? n : 96 * h + 64 + ropepos(j - 64); }
    else { const int h = n >> 7, j = n & 127; return j < 64 ? 64 * h + j : 512 + 64 * h + (j - 64); }
}
template <int MODE> __device__ __forceinline__ void p0_tr_item(const float* W, int K, int N, bf16* WT, int ldk, int koff, const float* kscale, LAS float* scr, int item, int lane) {
    const int nblk = N / 32, kb = item / nblk, nb = item % nblk, k0 = 64 * kb, n0 = 32 * nb;
#pragma unroll 8
    for (int i = 0; i < 32; ++i) { const int kk = 2 * i + (lane >> 5); float v = W[(size_t)(k0 + kk) * N + n0 + (lane & 31)]; if (kscale) v *= kscale[k0 + kk]; scr[kk * 33 + (lane & 31)] = v; }
    LDS_WAIT(); asm volatile("" ::: "memory");
    const int c = lane & 7;
#pragma unroll
    for (int j = 0; j < 4; ++j) { const int n = (lane >> 3) + 8 * j; const LAS float* s = scr + (8 * c) * 33 + n;
        v4u o; o.x = pk2(s[0 * 33], s[1 * 33]); o.y = pk2(s[2 * 33], s[3 * 33]); o.z = pk2(s[4 * 33], s[5 * 33]); o.w = pk2(s[6 * 33], s[7 * 33]);
        *(GAS v4u*)(WT + (size_t)rowmap<MODE>(n0 + n) * ldk + koff + k0 + 8 * c) = o; }
    LDS_WAIT(); asm volatile("" ::: "memory");
}

struct Ptrs {
    const float* in[35]; float* out; unsigned char* ws;
};
#define IN_X 0
#define IN_MEM 1
#define IN_RELB 2
#define IN_F1W1 3
#define IN_F1W3 4
#define IN_F1W2 5
#define IN_LN1G 6
#define IN_LN1B 7
#define IN_WIN 8
#define IN_QNG 9
#define IN_KVNG 10
#define IN_WQB 11
#define IN_WKVB 12
#define IN_LQ1 13
#define IN_LK1 14
#define IN_LQ2 15
#define IN_LK2 16
#define IN_DNG 17
#define IN_WGATE 18
#define IN_BGATE 19
#define IN_WUM 20
#define IN_WUD 21
#define IN_WOUT 22
#define IN_LN2G 23
#define IN_LN2B 24
#define IN_MWQ 25
#define IN_MWKV 26
#define IN_MWO 27
#define IN_LN3G 28
#define IN_LN3B 29
#define IN_F2W1 30
#define IN_F2W3 31
#define IN_F2W2 32
#define IN_LN4G 33
#define IN_LN4B 34

__device__ __forceinline__ void p0_prologue(const float* const* in, unsigned char* ws, LAS unsigned char* lds, int vcu, int G, int wave, int lane, int tid) {
    LAS float* scr = (LAS float*)(lds + RING_OFF + wave * 16384);
    const int gw = vcu * NWAVES + wave, NGW = G * NWAVES;
    constexpr int I_UP = (D / 64) * (FF / 32), I_DN = (FF / 64) * (D / 32), I_IN = (D / 64) * (2208 / 32), I_G = (D / 64) * (2048 / 32), I_QB = (QR / 64) * (768 / 32), I_KVB = (KVR / 64) * (1024 / 32),
                  I_Y = (512 / 64) * (D / 32), I_SQ = (D / 64) * (D / 32), I_MKV = (D / 64) * (2048 / 32);
    constexpr int NITEMS = 4 * I_UP + 2 * I_DN + I_IN + I_G + I_QB + I_KVB + 2 * I_Y + 3 * I_SQ + I_MKV;
    for (int it = gw; it < NITEMS; it += NGW) {
        int r = it;
        if (r < I_UP) { p0_tr_item<1>(in[IN_F1W1], D, FF, (bf16*)(ws + WS_W1C1), D, 0, nullptr, scr, r, lane); continue; } r -= I_UP;
        if (r < I_UP) { p0_tr_item<2>(in[IN_F1W3], D, FF, (bf16*)(ws + WS_W1C1), D, 0, nullptr, scr, r, lane); continue; } r -= I_UP;
        if (r < I_DN) { p0_tr_item<0>(in[IN_F1W2], FF, D, (bf16*)(ws + WS_W21), FF, 0, nullptr, scr, r, lane); continue; } r -= I_DN;
        if (r < I_UP) { p0_tr_item<1>(in[IN_F2W1], D, FF, (bf16*)(ws + WS_W1C2), D, 0, nullptr, scr, r, lane); continue; } r -= I_UP;
        if (r < I_UP) { p0_tr_item<2>(in[IN_F2W3], D, FF, (bf16*)(ws + WS_W1C2), D, 0, nullptr, scr, r, lane); continue; } r -= I_UP;
        if (r < I_DN) { p0_tr_item<0>(in[IN_F2W2], FF, D, (bf16*)(ws + WS_W22), FF, 0, nullptr, scr, r, lane); continue; } r -= I_DN;
        if (r < I_IN) { p0_tr_item<3>(in[IN_WIN], D, 2208, (bf16*)(ws + WS_WPG), D, 0, nullptr, scr, r, lane); continue; } r -= I_IN;
        if (r < I_G) { p0_tr_item<4>(in[IN_WGATE], D, 2048, (bf16*)(ws + WS_WPG), D, 0, nullptr, scr, r, lane); continue; } r -= I_G;
        if (r < I_QB) { p0_tr_item<5>(in[IN_WQB], QR, 768, (bf16*)(ws + WS_WQB), QR, 0, in[IN_QNG], scr, r, lane); continue; } r -= I_QB;
        if (r < I_KVB) { p0_tr_item<6>(in[IN_WKVB], KVR, 1024, (bf16*)(ws + WS_WKVB), KVR, 0, in[IN_KVNG], scr, r, lane); continue; } r -= I_KVB;
        if (r < I_Y) { p0_tr_item<1>(in[IN_WUM], 512, D, (bf16*)(ws + WS_WY), D, 0, nullptr, scr, r, lane); continue; } r -= I_Y;
        if (r < I_Y) { p0_tr_item<2>(in[IN_WUD], 512, D, (bf16*)(ws + WS_WY), D, 512, nullptr, scr, r, lane); continue; } r -= I_Y;
        if (r < I_SQ) { p0_tr_item<0>(in[IN_WOUT], D, D, (bf16*)(ws + WS_WO), D, 0, nullptr, scr, r, lane); continue; } r -= I_SQ;
        if (r < I_SQ) { p0_tr_item<0>(in[IN_MWQ], D, D, (bf16*)(ws + WS_WMQ), D, 0, nullptr, scr, r, lane); continue; } r -= I_SQ;
        if (r < I_MKV) { p0_tr_item<0>(in[IN_MWKV], D, 2048, (bf16*)(ws + WS_WMKV), D, 0, nullptr, scr, r, lane); continue; } r -= I_MKV;
        p0_tr_item<0>(in[IN_MWO], D, D, (bf16*)(ws + WS_WMO), D, 0, nullptr, scr, r, lane);
    }
    const int gt = vcu * (NWAVES * 64) + tid, NGT = G * NWAVES * 64;
    const v4u zero4 = {0u, 0u, 0u, 0u};
    for (int i = gt; i < 2048 * 64; i += NGT) { const int row = i >> 6, ch = i & 63; *(GAS v4u*)((bf16*)(ws + WS_WY) + (size_t)row * D + ((row & 128) ? 0 : 512) + ch * 8) = zero4; }
    for (int i = gt; i < 96 * 128; i += NGT) { const int row = 416 + (i >> 7), ch = i & 127; *(GAS v4u*)((bf16*)(ws + WS_WPG) + (size_t)row * D + ch * 8) = zero4; }
    { const GAS f32x4* x4 = (const GAS f32x4*)in[IN_X]; GAS v4u* o = (GAS v4u*)(ws + WS_HB);
      for (int i = gt; i < M * D / 8; i += NGT) { const f32x4 a = x4[2 * i], b = x4[2 * i + 1]; o[i] = pack8(a, b); }
      const GAS f32x4* m4 = (const GAS f32x4*)in[IN_MEM]; GAS v4u* om = (GAS v4u*)(ws + WS_MEMB);
      for (int i = gt; i < MM * D / 8; i += NGT) { const f32x4 a = m4[2 * i], b = m4[2 * i + 1]; om[i] = pack8(a, b); } }
    { float* tab = (float*)(ws + WS_TAB);
      for (int i = gt; i < SEQ * 16; i += NGT) { const int pos = i >> 4, k = i & 15;
          const double fr[16] = {1.0, 0.5623413251903491, 0.31622776601683794, 0.1778279410038923, 0.1, 0.05623413251903491, 0.03162277660168379, 0.01778279410038923, 0.01, 0.005623413251903491,
                                 0.0031622776601683794, 0.0017782794100389228, 0.001, 0.0005623413251903491, 0.00031622776601683794, 0.00017782794100389227};
          double f = 1.0;
#pragma unroll
          for (int q = 0; q < 16; ++q) f = (k == q) ? fr[q] : f;
          const double t = (double)pos * f * 0.15915494309189535;
          const float frac = (float)(t - __builtin_floor(t));
          tab[2 * i] = __builtin_amdgcn_cosf(frac); tab[2 * i + 1] = __builtin_amdgcn_sinf(frac); }
      float* bt = (float*)(ws + WS_TAB + 256 * 1024);
      for (int i = gt; i < 8 * 128; i += NGT) { const int mp = i >> 7, n = i & 127;
          int bk = n; if (n >= 16) { bk = 16 + (int)(__builtin_amdgcn_logf((float)n * 0.0625f) * (16.0f / 3.0f)); bk = bk > 31 ? 31 : bk; }
          bt[i] = (in[IN_RELB][bk * 8 + mp] - in[IN_RELB][31 * 8 + mp]) * LOG2E; }
      if (gt < 64) { const float a = in[IN_LQ1][gt] * in[IN_LK1][gt], b = in[IN_LQ2][gt] * in[IN_LK2][gt]; const float s1 = wave_sum(a), s2 = wave_sum(b);
          if (gt == 0) ((float*)(ws + WS_TAB + 260 * 1024))[0] = fexp2(s1 * LOG2E) - fexp2(s2 * LOG2E) + LAM_INIT; } }
}

__device__ __forceinline__ void ln_rows(const float* Z, const float* g, const float* b, float* HF, bf16* HB, int gw, int NGW, int lane) {
    f32x4 gv[4], bv[4];
#pragma unroll
    for (int j = 0; j < 4; ++j) { gv[j] = ((const GAS f32x4*)g)[lane + 64 * j]; bv[j] = ((const GAS f32x4*)b)[lane + 64 * j]; }
    for (int m = gw; m < M; m += NGW) {
        const GAS f32x4* xr = (const GAS f32x4*)(Z + (size_t)m * D) + lane;
        f32x4 v[4]; float s = 0.f;
#pragma unroll
        for (int j = 0; j < 4; ++j) { v[j] = xr[64 * j]; s += (v[j].x + v[j].y) + (v[j].z + v[j].w); }
        const float mean = wave_sum(s) * (1.f / D); float s2 = 0.f;
#pragma unroll
        for (int j = 0; j < 4; ++j) { v[j] = v[j] - mean; s2 += (v[j].x * v[j].x + v[j].y * v[j].y) + (v[j].z * v[j].z + v[j].w * v[j].w); }
        const float rstd = 1.f / sqrtf(wave_sum(s2) * (1.f / D) + LN_EPS);
        GAS f32x4* of = (GAS f32x4*)(HF + (size_t)m * D) + lane;
#pragma unroll
        for (int j = 0; j < 4; ++j) { v[j] = v[j] * rstd * gv[j] + bv[j]; of[64 * j] = v[j]; }
        if (HB) { GAS v2u* o8 = (GAS v2u*)(HB + (size_t)m * D) + lane;
#pragma unroll
            for (int j = 0; j < 4; ++j) { v2u w; w.x = cvtpk(v[j].x, v[j].y); w.y = cvtpk(v[j].z, v[j].w); o8[64 * j] = w; } }
    }
}

struct FSwiglu {
    bf16* U;
    __device__ __forceinline__ void operator()(int row, int pn, int cb, f32x4 a0, f32x4 a1, f32x4 b0, f32x4 b1) const {
        f32x4 r0, r1;
#pragma unroll
        for (int e = 0; e < 4; ++e) { r0[e] = a0[e] * sigmoidf_(a0[e]) * b0[e]; r1[e] = a1[e] * sigmoidf_(a1[e]) * b1[e]; }
        *(GAS v4u*)(U + (size_t)row * FF + 128 * pn + cb) = pack8(r0, r1);
    }
};
struct FResid {
    const float* base; float* Z; float s;
    __device__ __forceinline__ void operator()(int row, int pn, int cb, f32x4 a0, f32x4 a1, f32x4 b0, f32x4 b1) const {
        const size_t o = (size_t)row * D + 256 * pn + cb;
        const f32x4 x0 = *(const GAS f32x4*)(base + o), x1 = *(const GAS f32x4*)(base + o + 4), y0 = *(const GAS f32x4*)(base + o + 128), y1 = *(const GAS f32x4*)(base + o + 132);
        *(GAS f32x4*)(Z + o) = x0 * ALPHA + a0 * s; *(GAS f32x4*)(Z + o + 4) = x1 * ALPHA + a1 * s;
        *(GAS f32x4*)(Z + o + 128) = y0 * ALPHA + b0 * s; *(GAS f32x4*)(Z + o + 132) = y1 * ALPHA + b1 * s;
    }
};
struct FPlain {
    bf16* O; int ldc; float s;
    __device__ __forceinline__ void operator()(int row, int pn, int cb, f32x4 a0, f32x4 a1, f32x4 b0, f32x4 b1) const {
        bf16* p = O + (size_t)row * ldc + 256 * pn + cb;
        *(GAS v4u*)p = pack8(a0 * s, a1 * s); *(GAS v4u*)(p + 128) = pack8(b0 * s, b1 * s);
    }
};
__device__ __forceinline__ float ssq8(f32x4 a, f32x4 b) { return (a[0] * a[0] + a[1] * a[1]) + (a[2] * a[2] + a[3] * a[3]) + (b[0] * b[0] + b[1] * b[1]) + (b[2] * b[2] + b[3] * b[3]); }
__device__ __forceinline__ float red_fq(float s) { s += __shfl_xor(s, 16); s += __shfl_xor(s, 32); return s; }
__device__ __forceinline__ void rope8(f32x4& x1, f32x4& x2, const float* tabrow, int g) {
    const GAS f32x4* t = (const GAS f32x4*)(tabrow + 8 * g);
    const f32x4 t0 = t[0], t1 = t[1];
    f32x4 o1, o2;
    o1[0] = x1[0] * t0[0] - x2[0] * t0[1]; o2[0] = x2[0] * t0[0] + x1[0] * t0[1];
    o1[1] = x1[1] * t0[2] - x2[1] * t0[3]; o2[1] = x2[1] * t0[2] + x1[1] * t0[3];
    o1[2] = x1[2] * t1[0] - x2[2] * t1[1]; o2[2] = x2[2] * t1[0] + x1[2] * t1[1];
    o1[3] = x1[3] * t1[2] - x2[3] * t1[3]; o2[3] = x2[3] * t1[2] + x1[3] * t1[3];
    x1 = o1; x2 = o2;
}
struct FProj {
    bf16 *CQ, *CKV, *KROPE, *QKVD, *G; float *SSQQ, *SSQKV; const float* bgate; const float* rtab;
    __device__ __forceinline__ void operator()(int row, int pn, int cb, f32x4 a0, f32x4 a1, f32x4 b0, f32x4 b1) const {
        const int wc = cb >> 5, fq = (cb >> 3) & 3;
        if (pn == 0) {
            bf16* p = CQ + (size_t)row * QR + cb; *(GAS v4u*)p = pack8(a0, a1); *(GAS v4u*)(p + 128) = pack8(b0, b1);
            const float s = red_fq(ssq8(a0, a1) + ssq8(b0, b1)); if (fq == 0) SSQQ[(size_t)row * 8 + wc] = s;
        } else if (pn == 1) {
            *(GAS v4u*)(CQ + (size_t)row * QR + 256 + cb) = pack8(a0, a1);
            const float s = red_fq(ssq8(a0, a1)); if (fq == 0) SSQQ[(size_t)row * 8 + 4 + wc] = s;
            if (wc == 0) { rope8(b0, b1, rtab + (size_t)(row & (SEQ - 1)) * 32, fq); *(GAS v4u*)(KROPE + (size_t)row * 32 + cb) = pack8(b0, b1); }
        } else if (pn == 2) {
            bf16* p = CKV + (size_t)row * KVR + cb; *(GAS v4u*)p = pack8(a0, a1); *(GAS v4u*)(p + 128) = pack8(b0, b1);
            const float s = red_fq(ssq8(a0, a1) + ssq8(b0, b1)); if (fq == 0) SSQKV[(size_t)row * 4 + wc] = s;
        } else if (pn < 9) {
            const int t = pn - 3; bf16* base = QKVD + (size_t)(t >> 1) * ((size_t)M * 512); const float sc = t < 2 ? C2_DIFF : 1.0f;
            bf16* p = base + (size_t)row * 512 + 256 * (t & 1) + cb; *(GAS v4u*)p = pack8(a0 * sc, a1 * sc); *(GAS v4u*)(p + 128) = pack8(b0 * sc, b1 * sc);
        } else {
            const int c0 = 256 * (pn - 9) + cb;
            const f32x4 ba0 = *(const GAS f32x4*)(bgate + c0), ba1 = *(const GAS f32x4*)(bgate + c0 + 4), bb0 = *(const GAS f32x4*)(bgate + c0 + 128), bb1 = *(const GAS f32x4*)(bgate + c0 + 132);
            f32x4 r0, r1, r2, r3;
#pragma unroll
            for (int e = 0; e < 4; ++e) { r0[e] = sigmoidf_(a0[e] + ba0[e]); r1[e] = sigmoidf_(a1[e] + ba1[e]); r2[e] = sigmoidf_(b0[e] + bb0[e]); r3[e] = sigmoidf_(b1[e] + bb1[e]); }
            bf16* p = G + (size_t)row * 2048 + c0; *(GAS v4u*)p = pack8(r0, r1); *(GAS v4u*)(p + 128) = pack8(r2, r3);
        }
    }
};
struct FQup {
    bf16* Q; const float* SSQQ; const float* rtab;
    __device__ __forceinline__ void operator()(int row, int pn, int cb, f32x4 a0, f32x4 a1, f32x4 b0, f32x4 b1) const {
        const GAS f32x4* sp = (const GAS f32x4*)(SSQQ + (size_t)row * 8); const f32x4 s0 = sp[0], s1 = sp[1];
        const float ss = ((s0[0] + s0[1]) + (s0[2] + s0[3])) + ((s1[0] + s1[1]) + (s1[2] + s1[3]));
        const float sc = C2_MLA / sqrtf(ss * (1.0f / QR) + RMS_EPS);
        a0 = a0 * sc; a1 = a1 * sc; b0 = b0 * sc; b1 = b1 * sc;
        const float* tr = rtab + (size_t)(row & (SEQ - 1)) * 32;
        const int ca = 256 * pn + cb, cbb = ca + 128;
        { const int j = ca % 96; if (j >= 64) rope8(a0, a1, tr, (j - 64) >> 3); }
        { const int j = cbb % 96; if (j >= 64) rope8(b0, b1, tr, (j - 64) >> 3); }
        *(GAS v4u*)(Q + (size_t)row * 768 + ca) = pack8(a0, a1); *(GAS v4u*)(Q + (size_t)row * 768 + cbb) = pack8(b0, b1); asm volatile("" ::: "memory");
    }
};
struct FKVup {
    bf16* KV; const float* SSQKV;
    __device__ __forceinline__ void operator()(int row, int pn, int cb, f32x4 a0, f32x4 a1, f32x4 b0, f32x4 b1) const {
        const f32x4 s0 = *(const GAS f32x4*)(SSQKV + (size_t)row * 4);
        const float sc = 1.0f / sqrtf(((s0[0] + s0[1]) + (s0[2] + s0[3])) * (1.0f / KVR) + RMS_EPS);
        bf16* p = KV + (size_t)row * 1024 + 256 * pn + cb; *(GAS v4u*)p = pack8(a0 * sc, a1 * sc); *(GAS v4u*)(p + 128) = pack8(b0 * sc, b1 * sc);
    }
};
struct FYGate {
    bf16* MIX; const bf16* G;
    __device__ __forceinline__ void operator()(int row, int pn, int cb, f32x4 a0, f32x4 a1, f32x4 b0, f32x4 b1) const {
        const int c = 128 * pn + cb; f32x4 gm0, gm1, gd0, gd1;
        unpack8(*(const GAS v4u*)(G + (size_t)row * 2048 + c), gm0, gm1); unpack8(*(const GAS v4u*)(G + (size_t)row * 2048 + 1024 + c), gd0, gd1);
        *(GAS v4u*)(MIX + (size_t)row * D + c) = pack8(gm0 * a0 + gd0 * b0, gm1 * a1 + gd1 * b1);
    }
};

__device__ __forceinline__ int crow(int r, int hi) { return (r & 3) + 8 * (r >> 2) + 4 * hi; }
typedef short v4i16_t __attribute__((ext_vector_type(4)));
__device__ __forceinline__ s16x4 vtr(const LAS unsigned char* p) { return __builtin_bit_cast(s16x4, __builtin_amdgcn_ds_read_tr16_b64_v4i16((LAS v4i16_t*)p)); }
constexpr float NEGBIG = -1.0e30f;
constexpr int ATT_WSF_OFF = 53248, ATT_BIAS_OFF = 55296, BIAS_PITCH = 320;
template <int DQK, int DV, int KW1, bool CAUSAL, bool BIAS>
__device__ __forceinline__ void attn_core(LAS unsigned char* lds, const bf16* Qp, const bf16* K1, int ldk1, const bf16* K2, int ldk2, const bf16* V, int ldv,
                                          int NT, int qabs0, const LAS float* biasrow, f32x16 (&o)[DV / 32], int tid, int lane, int wave) {
    constexpr int KST = (DQK + 8) * 2, VST = (DV + 8) * 2, KCH = DQK / 8, VCH = DV / 8, NKS = DQK / 16, NCB = DV / 32;
    constexpr int KS_OFF = 0, VS_OFF = 64 * KST;
    static_assert(VS_OFF + 64 * VST <= ATT_WSF_OFF, "attention LDS map");
    const int r32 = lane & 31, hi = lane >> 5;
    bf16x8 qf[NKS];
#pragma unroll
    for (int ks = 0; ks < NKS; ++ks) qf[ks] = *(const GAS bf16x8*)(Qp + 16 * ks + 8 * hi);
#pragma unroll
    for (int cb = 0; cb < NCB; ++cb) o[cb] = f32x16{};
    float m = NEGBIG, l = 0.f;
    const LAS unsigned char* ka = lds + KS_OFF + r32 * KST + hi * 16;
    const LAS unsigned char* va = lds + VS_OFF + (4 * hi + ((lane & 15) >> 2)) * VST + (((lane >> 4) & 1) * 16 + (lane & 3) * 4) * 2;
    LAS float* wsf = (LAS float*)(lds + ATT_WSF_OFF) + wave * 64;
    const LAS float* wsr = wsf + 4 * hi;
    for (int t = 0; t < NT; ++t) {
        __syncthreads();
        { const GAS unsigned char* k1t = (const GAS unsigned char*)(K1 + (size_t)(64 * t) * ldk1); const GAS unsigned char* k2t = (const GAS unsigned char*)(K2 + (size_t)(64 * t) * ldk2);
          const GAS unsigned char* vt = (const GAS unsigned char*)(V + (size_t)(64 * t) * ldv);
#pragma unroll
          for (int i = 0; i < (64 * KCH + NWAVES * 64 - 1) / (NWAVES * 64); ++i) { const int c = tid + i * NWAVES * 64; if ((64 * KCH) % (NWAVES * 64) == 0 || c < 64 * KCH) { const int row = c / KCH, ch = c - row * KCH; const int e0 = ch * 8;
              const v4u kv = (e0 < KW1) ? *(const GAS v4u*)(k1t + (unsigned)((row * ldk1 + e0) * 2)) : *(const GAS v4u*)(k2t + (unsigned)((row * ldk2 + (e0 - KW1)) * 2));
              *(LAS v4u*)(lds + KS_OFF + row * KST + e0 * 2) = kv; } }
#pragma unroll
          for (int i = 0; i < (64 * VCH) / (NWAVES * 64); ++i) { const int c = tid + i * NWAVES * 64; const int row = c / VCH, ch = c - row * VCH;
              *(LAS v4u*)(lds + VS_OFF + row * VST + ch * 16) = *(const GAS v4u*)(vt + (unsigned)((row * ldv + ch * 8) * 2)); } }
        __syncthreads();
        if (CAUSAL && 64 * t > qabs0 + 31) continue;
        f32x16 p0 = f32x16{}, p1 = f32x16{};
#pragma unroll
        for (int ks = 0; ks < NKS; ++ks) {
            const bf16x8 a0 = *(const LAS bf16x8*)(ka + ks * 32), a1 = *(const LAS bf16x8*)(ka + 32 * KST + ks * 32);
            p0 = __builtin_amdgcn_mfma_f32_32x32x16_bf16(a0, qf[ks], p0, 0, 0, 0);
            p1 = __builtin_amdgcn_mfma_f32_32x32x16_bf16(a1, qf[ks], p1, 0, 0, 0);
        }
        const int qrel = qabs0 + r32 - 64 * t - 4 * hi;
        if (BIAS) { if (qabs0 - (64 * t + 63) < 128) {
            const LAS float* bp = biasrow + (qrel + 64 - 59);
#pragma unroll
            for (int r = 0; r < 16; ++r) { constexpr int dummy = 0; const int C = (r & 3) + 8 * (r >> 2); p0[r] += bp[59 - C + dummy]; p1[r] += bp[27 - C]; } } }
        if (CAUSAL) { if (64 * t + 63 > qabs0) {
#pragma unroll
            for (int r = 0; r < 16; ++r) { const int C = (r & 3) + 8 * (r >> 2); if (C > qrel) p0[r] = NEGBIG; if (C + 32 > qrel) p1[r] = NEGBIG; } } }
        float rm = p0[0];
#pragma unroll
        for (int r = 1; r < 16; ++r) rm = fmaxf(rm, p0[r]);
#pragma unroll
        for (int r = 0; r < 16; ++r) rm = fmaxf(rm, p1[r]);
        rm = fmaxf(rm, __shfl_xor(rm, 32));
        const float mn = fmaxf(m, rm), alpha = fexp2(m - mn); m = mn;
        if (hi == 0) wsf[r32] = alpha;
        float rs = 0.f;
#pragma unroll
        for (int r = 0; r < 16; ++r) { p0[r] = fexp2(p0[r] - mn); p1[r] = fexp2(p1[r] - mn); rs += p0[r] + p1[r]; }
        rs += __shfl_xor(rs, 32);
        l = l * alpha + rs;
#pragma unroll
        for (int r = 0; r < 16; ++r) { const float ar = wsr[(r & 3) + 8 * (r >> 2)];
#pragma unroll
            for (int cb = 0; cb < NCB; ++cb) o[cb][r] *= ar; }
        bf16x8 pa[4];
#pragma unroll
        for (int s = 0; s < 2; ++s) {
            v4u w0, w1;
            w0.x = cvtpk(p0[8 * s + 0], p0[8 * s + 1]); w0.y = cvtpk(p0[8 * s + 2], p0[8 * s + 3]); w0.z = cvtpk(p0[8 * s + 4], p0[8 * s + 5]); w0.w = cvtpk(p0[8 * s + 6], p0[8 * s + 7]);
            w1.x = cvtpk(p1[8 * s + 0], p1[8 * s + 1]); w1.y = cvtpk(p1[8 * s + 2], p1[8 * s + 3]); w1.z = cvtpk(p1[8 * s + 4], p1[8 * s + 5]); w1.w = cvtpk(p1[8 * s + 6], p1[8 * s + 7]);
            pa[s] = __builtin_bit_cast(bf16x8, w0); pa[2 + s] = __builtin_bit_cast(bf16x8, w1);
        }
#pragma unroll
        for (int cb = 0; cb < NCB; ++cb)
#pragma unroll
            for (int s = 0; s < 4; ++s) {
                const s16x4 lo = vtr(va + (16 * s) * VST + cb * 64), hh = vtr(va + (16 * s + 8) * VST + cb * 64);
                const bf16x8 vf = {lo[0], lo[1], lo[2], lo[3], hh[0], hh[1], hh[2], hh[3]};
                o[cb] = __builtin_amdgcn_mfma_f32_32x32x16_bf16(pa[s], vf, o[cb], 0, 0, 0);
            }
    }
    if (hi == 0) wsf[r32] = 1.0f / l;
#pragma unroll
    for (int r = 0; r < 16; ++r) { const float lr = wsr[(r & 3) + 8 * (r >> 2)];
#pragma unroll
        for (int cb = 0; cb < NCB; ++cb) o[cb][r] *= lr; }
}
template <int NCB> __device__ __forceinline__ void attn_store(bf16* Orow0, int ldo, const f32x16 (&o)[NCB], int lane) {
    const int r32 = lane & 31, hi = lane >> 5;
#pragma unroll
    for (int r = 0; r < 16; ++r)
#pragma unroll
        for (int cb = 0; cb < NCB; ++cb) Orow0[(size_t)crow(r, hi) * ldo + 32 * cb + r32] = (bf16)f2bf(o[cb][r]);
}

__device__ __forceinline__ void attn_phase_mixer(unsigned char* ws, float* out, const float* dng, LAS unsigned char* lds, int vcu, int G, int tid, int lane, int wave, const unsigned* zero_word) {
    { const float* bt = (const float*)(ws + WS_TAB + 256 * 1024); LAS float* lb = (LAS float*)(lds + ATT_BIAS_OFF);
      for (int i = tid; i < 8 * BIAS_PITCH; i += NWAVES * 64) { const int mp = i / BIAS_PITCH, n = i - mp * BIAS_PITCH - 64; lb[i] = (n >= 0 && n < 128) ? bt[mp * 128 + n] : 0.f; } }
    const float lam = ((const float*)(ws + WS_TAB + 260 * 1024))[0];
    __syncthreads();
    const bf16* QMLA = (const bf16*)((unsigned char*)out + OUT_QMLA); const bf16* KVMLA = (const bf16*)(ws + WS_HB); const bf16* KROPE = (const bf16*)(ws + WS_KROPE);
    const bf16* QD = (const bf16*)(ws + WS_QD); const bf16* KD = (const bf16*)(ws + WS_KD); const bf16* VD = (const bf16*)(ws + WS_VD);
    bf16* OMD = (bf16*)((unsigned char*)out + OUT_OMD);
    const int r32 = lane & 31, hi = lane >> 5;
    for (int i = 0; i < 2; ++i) {
        const int d = (i == 0) ? vcu : 511 - vcu; if (vcu >= 256) break;
        const int qb = 7 - (d >> 6), rem = d & 63; const int q0 = 256 * qb, NT = (q0 + 256) / 64, qabs0 = q0 + 32 * wave;
        {
            const int b = rem >> 2, h = rem & 3; const size_t rb = (size_t)b * SEQ, qrow = rb + qabs0 + r32;
            f32x16 o1[4];
            LAS unsigned* park = (LAS unsigned*)(lds + 65536 + wave * 8192) + lane;
            attn_core<64, 128, 64, true, true>(lds, QD + qrow * 512 + 128 * h + 64, KD + rb * 512 + 128 * h + 64, 512, nullptr, 0, VD + rb * 512 + 128 * h, 512, NT, qabs0,
                                               (const LAS float*)(lds + ATT_BIAS_OFF) + BIAS_PITCH * (2 * h + 1), o1, tid, lane, wave);
#pragma unroll
            for (int cb = 0; cb < 4; ++cb)
#pragma unroll
                for (int r = 0; r < 8; ++r) park[(cb * 8 + r) * 64] = cvtpk(o1[cb][2 * r], o1[cb][2 * r + 1]);
            attn_core<64, 128, 64, true, true>(lds, QD + qrow * 512 + 128 * h, KD + rb * 512 + 128 * h, 512, nullptr, 0, VD + rb * 512 + 128 * h, 512, NT, qabs0,
                                               (const LAS float*)(lds + ATT_BIAS_OFF) + BIAS_PITCH * (2 * h), o1, tid, lane, wave);
            float gg[4];
#pragma unroll
            for (int cb = 0; cb < 4; ++cb) gg[cb] = dng[32 * cb + r32] * (1.0f - LAM_INIT);
#pragma unroll
            for (int r = 0; r < 16; ++r) {
                float ss = 0.f;
#pragma unroll
                for (int cb = 0; cb < 4; ++cb) { const unsigned w = park[(cb * 8 + (r >> 1)) * 64]; const float o2v = __builtin_bit_cast(float, (r & 1) ? (w & 0xffff0000u) : (w << 16));
                    o1[cb][r] -= lam * o2v; ss += o1[cb][r] * o1[cb][r]; }
                ss += __shfl_xor(ss, 1); ss += __shfl_xor(ss, 2); ss += __shfl_xor(ss, 4); ss += __shfl_xor(ss, 8); ss += __shfl_xor(ss, 16);
                const float rinv = 1.0f / sqrtf(ss * (1.0f / 128.0f) + RMS_EPS);
#pragma unroll
                for (int cb = 0; cb < 4; ++cb) o1[cb][r] *= rinv * gg[cb];
            }
            attn_store<4>(OMD + (rb + qabs0) * 1024 + 512 + 128 * h, 1024, o1, lane);
        }
    }
    __syncthreads();
    const int lane2 = (int)((threadIdx.x | *(volatile GAS unsigned*)zero_word) & 63u); const int r32b = lane2 & 31;
    for (int i = 0; i < 4; ++i) {
        const int d = (i & 1) ? 511 - vcu : vcu; if (vcu >= 256) break;
        const int qb = 7 - (d >> 6), rem = (d & 63) + 64 * (i >> 1); const int q0 = 256 * qb, NT = (q0 + 256) / 64, qabs0 = q0 + 32 * wave;
        {
            const int b = rem >> 3, h = rem & 7; const size_t rb = (size_t)b * SEQ, qrow = rb + qabs0 + r32b;
            f32x16 o[2];
            attn_core<96, 64, 64, true, false>(lds, QMLA + qrow * 768 + 96 * h, KVMLA + rb * 1024 + 64 * h, 1024, KROPE + rb * 32, 32, KVMLA + rb * 1024 + 512 + 64 * h, 1024, NT, qabs0,
                                               nullptr, o, tid, lane2, wave);
            attn_store<2>(OMD + (rb + qabs0) * 1024 + 64 * h, 1024, o, lane2);
        }
    }
}
__device__ __forceinline__ void attn_phase_mem(unsigned char* ws, LAS unsigned char* lds, int vcu, int G, int tid, int lane, int wave) {
    const bf16* QM = (const bf16*)(ws + WS_QM); const bf16* KVM = (const bf16*)(ws + WS_KVM); bf16* OMEM = (bf16*)(ws + WS_OMEM);
    const int r32 = lane & 31;
    constexpr int NU = BATCH * 4 * 8;
    for (int u = vcu; u < NU; u += G) {
        const int b = u >> 5, h = (u >> 3) & 3, qb = u & 7; const int qabs0 = 256 * qb + 32 * wave; const size_t rb = (size_t)b * SEQ, qrow = rb + qabs0 + r32, kb = (size_t)b * MEML;
#pragma unroll 1
        for (int half = 0; half < 2; ++half) {
            f32x16 o[4];
            attn_core<256, 128, 256, false, false>(lds, QM + qrow * 1024 + 256 * h, KVM + kb * 2048 + 256 * h, 2048, nullptr, 0, KVM + kb * 2048 + 1024 + 256 * h + 128 * half, 2048, MEML / 64, qabs0,
                                                   nullptr, o, tid, lane, wave);
            attn_store<4>(OMEM + (rb + qabs0) * 1024 + 256 * h + 128 * half, 1024, o, lane);
        }
    }
}

struct Args { const float* in[35]; float* out; unsigned char* ws; int ph_lo, ph_hi; };
__global__ void __launch_bounds__(NWAVES * 64, 2) mk_fwd(Args args) {
    extern __shared__ __attribute__((aligned(16))) unsigned char lds_raw[];
    LAS unsigned char* lds = (LAS unsigned char*)lds_raw;
    volatile LAS unsigned* MISC = (volatile LAS unsigned*)(lds + MISC_OFF);
    const int tid = threadIdx.x, lane = tid & 63, wave = __builtin_amdgcn_readfirstlane(tid >> 6);
    const int G = gridDim.x; const int bx = blockIdx.x; const int vcu = (G % 8 == 0) ? (bx % 8) * (G / 8) + bx / 8 : bx;
    unsigned char* ws = args.ws; float* out = args.out; const float* const* in = args.in;
    gu32* ctl = (gu32*)(ws + WS_CTL);
    for (int u = tid; u < (LDS_BYTES - LDSCTL_OFF) / 4; u += NWAVES * 64) ((LAS unsigned*)(lds + LDSCTL_OFF))[u] = 0u;
    __syncthreads();
    XcdBarrier bar; bar.bar = (unsigned*)(ctl + CW_BAR); bar.x = 0; bar.st = nullptr;
    if (MK_ONE_LAUNCH) bar = xcd_barrier_post((unsigned*)(ctl + CW_BAR), MISC + 8);
    const int lo = args.ph_lo, hi = args.ph_hi;
#ifndef PH_MASK
#define PH_MASK 0x1ffff
#endif
#define IN(k) ((((PH_MASK) >> (k)) & 1) && lo <= (k) && (k) < hi)
#define OPQ_STR2(x) #x
#define OPQ_STR(x) OPQ_STR2(x)
#define OPQ_TID() const int tid_ = tid; const int lane_ = (int)((threadIdx.x | *(volatile GAS unsigned*)(ctl + 8)) & 63u)
#define SEAM(k) do { if (IN(k) && IN((k) + 1)) xcd_barrier(bar); } while (0)
    const int gw = vcu * NWAVES + wave, NGW = G * NWAVES;
    float* HF = (float*)(ws + WS_HF); bf16* HB = (bf16*)(ws + WS_HB); bf16* U = (bf16*)(ws + WS_U);

    if (IN(PH_PRO)) { OPQ_TID(); p0_prologue(in, ws, lds, vcu, G, wave, lane_, tid_); }
    SEAM(PH_PRO);
    if (IN(PH_FFN1UP)) {
        { pg8::Gemm g{HB, (const bf16*)(ws + WS_W1C1), M, 2 * FF, D}; pg8::StaticOrder S; S.init(M, 2 * FF, G, bx); EpiRow<FSwiglu> E{{U}};
          pg8::gemm_phase<EpiRow<FSwiglu>, pg8::StaticOrder, true, true>(lds + RING_OFF, g, S, E, (const unsigned*)(ctl + 8)); }
        { pg8::Gemm g{(const bf16*)(ws + WS_MEMB), (const bf16*)(ws + WS_WMKV), MM, 2048, D}; pg8::StaticOrder S; S.init(MM, 2048, G, bx); EpiRow<FPlain> E{{(bf16*)(ws + WS_KVM), 2048, 1.0f}};
          pg8::gemm_phase<EpiRow<FPlain>, pg8::StaticOrder, true, true>(lds + RING_OFF, g, S, E, (const unsigned*)(ctl + 8)); }
    }
    SEAM(PH_FFN1UP);
    if (IN(PH_FFN1DN)) {
        pg8::Gemm g{U, (const bf16*)(ws + WS_W21), M, D, FF}; pg8::StaticOrder S; S.init(M, D, G, bx); EpiRow<FResid> E{{in[IN_X], out, 0.5f}};
        pg8::gemm_phase<EpiRow<FResid>, pg8::StaticOrder, true, true>(lds + RING_OFF, g, S, E, (const unsigned*)(ctl + 8));
    }
    SEAM(PH_FFN1DN);
    if (IN(PH_LN1)) { OPQ_TID(); ln_rows(out, in[IN_LN1G], in[IN_LN1B], HF, HB, gw, NGW, lane_); }
    SEAM(PH_LN1);
    if (IN(PH_PROJ)) {
        pg8::Gemm g{HB, (const bf16*)(ws + WS_WPG), M, NPG, D}; pg8::StaticOrder S; S.init(M, NPG, G, bx);
        EpiRow<FProj> E{{(bf16*)((unsigned char*)out + OUT_CQ), (bf16*)((unsigned char*)out + OUT_CKV), (bf16*)(ws + WS_KROPE), (bf16*)(ws + WS_QD), (bf16*)(ws + WS_G),
                         (float*)(ws + WS_SSQQ), (float*)(ws + WS_SSQKV), in[IN_BGATE], (const float*)(ws + WS_TAB)}};
        pg8::gemm_phase<EpiRow<FProj>, pg8::StaticOrder, true, true>(lds + RING_OFF, g, S, E, (const unsigned*)(ctl + 8));
    }
    SEAM(PH_PROJ);
    if (IN(PH_QKVUP)) {
#ifndef NO_QUP
        { pg8::Gemm g{(const bf16*)((unsigned char*)out + OUT_CQ), (const bf16*)(ws + WS_WQB), M, 768, QR}; pg8::StaticOrder S; S.init(M, 768, G, bx);
          EpiRow<FQup> E{{(bf16*)((unsigned char*)out + OUT_QMLA), (const float*)(ws + WS_SSQQ), (const float*)(ws + WS_TAB)}};
          pg8::gemm_phase<EpiRow<FQup>, pg8::StaticOrder, true, true>(lds + RING_OFF, g, S, E, (const unsigned*)(ctl + 8)); }
#endif
#ifndef NO_KVUP
        { pg8::Gemm g{(const bf16*)((unsigned char*)out + OUT_CKV), (const bf16*)(ws + WS_WKVB), M, 1024, KVR}; pg8::StaticOrder S; S.init(M, 1024, G, bx);
          EpiRow<FKVup> E{{HB, (const float*)(ws + WS_SSQKV)}};
          pg8::gemm_phase<EpiRow<FKVup>, pg8::StaticOrder, true, true>(lds + RING_OFF, g, S, E, (const unsigned*)(ctl + 8)); }
#endif
    }
    SEAM(PH_QKVUP);
    if (IN(PH_ATTN)) { OPQ_TID(); attn_phase_mixer(ws, out, in[IN_DNG], lds, vcu, G, tid_, lane_, wave, (const unsigned*)(ctl + 8)); }
    SEAM(PH_ATTN);
    if (IN(PH_YG)) {
        pg8::Gemm g{(const bf16*)((unsigned char*)out + OUT_OMD), (const bf16*)(ws + WS_WY), M, 2048, D}; pg8::StaticOrder S; S.init(M, 2048, G, bx); EpiRow<FYGate> E{{HB, (const bf16*)(ws + WS_G)}};
        pg8::gemm_phase<EpiRow<FYGate>, pg8::StaticOrder, true, true>(lds + RING_OFF, g, S, E, (const unsigned*)(ctl + 8));
    }
    SEAM(PH_YG);
    if (IN(PH_WO)) {
        pg8::Gemm g{HB, (const bf16*)(ws + WS_WO), M, D, D}; pg8::StaticOrder S; S.init(M, D, G, bx); EpiRow<FResid> E{{HF, out, 1.0f}};
        pg8::gemm_phase<EpiRow<FResid>, pg8::StaticOrder, true, true>(lds + RING_OFF, g, S, E, (const unsigned*)(ctl + 8));
    }
    SEAM(PH_WO);
    if (IN(PH_LN2)) { OPQ_TID(); ln_rows(out, in[IN_LN2G], in[IN_LN2B], HF, HB, gw, NGW, lane_); }
    SEAM(PH_LN2);
    if (IN(PH_MEMQ)) {
        pg8::Gemm g{HB, (const bf16*)(ws + WS_WMQ), M, D, D}; pg8::StaticOrder S; S.init(M, D, G, bx); EpiRow<FPlain> E{{(bf16*)(ws + WS_QM), D, C2_MEM}};
        pg8::gemm_phase<EpiRow<FPlain>, pg8::StaticOrder, true, true>(lds + RING_OFF, g, S, E, (const unsigned*)(ctl + 8));
    }
    SEAM(PH_MEMQ);
    if (IN(PH_MEMATT)) { OPQ_TID(); attn_phase_mem(ws, lds, vcu, G, tid_, lane_, wave); }
    SEAM(PH_MEMATT);
    if (IN(PH_MEMO)) {
        pg8::Gemm g{(const bf16*)(ws + WS_OMEM), (const bf16*)(ws + WS_WMO), M, D, D}; pg8::StaticOrder S; S.init(M, D, G, bx); EpiRow<FResid> E{{HF, out, 1.0f}};
        pg8::gemm_phase<EpiRow<FResid>, pg8::StaticOrder, true, true>(lds + RING_OFF, g, S, E, (const unsigned*)(ctl + 8));
    }
    SEAM(PH_MEMO);
    if (IN(PH_LN3)) { OPQ_TID(); ln_rows(out, in[IN_LN3G], in[IN_LN3B], HF, HB, gw, NGW, lane_); }
    SEAM(PH_LN3);
    if (IN(PH_FFN2UP)) {
        pg8::Gemm g{HB, (const bf16*)(ws + WS_W1C2), M, 2 * FF, D}; pg8::StaticOrder S; S.init(M, 2 * FF, G, bx); EpiRow<FSwiglu> E{{U}};
        pg8::gemm_phase<EpiRow<FSwiglu>, pg8::StaticOrder, true, true>(lds + RING_OFF, g, S, E, (const unsigned*)(ctl + 8));
    }
    SEAM(PH_FFN2UP);
    if (IN(PH_FFN2DN)) {
        pg8::Gemm g{U, (const bf16*)(ws + WS_W22), M, D, FF}; pg8::StaticOrder S; S.init(M, D, G, bx); EpiRow<FResid> E{{HF, out, 0.5f}};
        pg8::gemm_phase<EpiRow<FResid>, pg8::StaticOrder, true, true>(lds + RING_OFF, g, S, E, (const unsigned*)(ctl + 8));
    }
    SEAM(PH_FFN2DN);
    if (IN(PH_LN4)) { OPQ_TID(); ln_rows(out, in[IN_LN4G], in[IN_LN4B], out, nullptr, gw, NGW, lane_); }
#undef IN
#undef SEAM
}

extern "C" void kernel_launch(void* const* d_in, const int* in_sizes, int n_in, void* d_out, int out_size, void* d_ws, size_t ws_size, hipStream_t stream) {
    static int grid = 0;
    if (grid == 0) {
        if (n_in != 35 || in_sizes[0] != M * D || out_size != M * D || ws_size < WS_END) { fprintf(stderr, "kernel_launch: unexpected shapes (n_in %d, in0 %d, out %d, ws %zu); nothing launched\n", n_in, n_in > 0 ? in_sizes[0] : -1, out_size, ws_size); grid = -1; return; }
        int dev = 0, cus = 0, per_cu = 0;
        if (hipGetDevice(&dev) != hipSuccess || hipDeviceGetAttribute(&cus, hipDeviceAttributeMultiprocessorCount, dev) != hipSuccess) { grid = -1; return; }
        if (hipFuncSetAttribute((const void*)mk_fwd, hipFuncAttributeMaxDynamicSharedMemorySize, LDS_BYTES) != hipSuccess) { fprintf(stderr, "kernel_launch: hipFuncSetAttribute failed\n"); grid = -1; return; }
        if (hipOccupancyMaxActiveBlocksPerMultiprocessor(&per_cu, (const void*)mk_fwd, NWAVES * 64, LDS_BYTES) != hipSuccess || per_cu < 1) { fprintf(stderr, "kernel_launch: occupancy query says %d blocks per CU\n", per_cu); per_cu = 1; }
        (void)hipGetLastError();
        grid = cus * (per_cu < 1 ? 1 : 1);
        if (grid != 256) { fprintf(stderr, "kernel_launch: this kernel's unit maps need exactly 256 workgroups (one per CU of a 256-CU device); device has %d CUs; nothing launched\n", cus); grid = -1; return; }
    }
    if (grid < 0) return;
    if (hipMemsetAsync((char*)d_ws + WS_CTL, 0, CTL_ZERO_BYTES, stream) != hipSuccess) { fprintf(stderr, "kernel_launch: hipMemsetAsync failed\n"); return; }
    Args a{};
    for (int i = 0; i < 35; ++i) a.in[i] = (const float*)d_in[i];
    a.out = (float*)d_out; a.ws = (unsigned char*)d_ws;
#if MK_ONE_LAUNCH
    a.ph_lo = 0; a.ph_hi = NPHASE;
    { void* kargs[] = {(void*)&a};
      hipError_t e = hipLaunchCooperativeKernel((const void*)mk_fwd, dim3(grid), dim3(NWAVES * 64), kargs, LDS_BYTES, stream);
      if (e != hipSuccess) { fprintf(stderr, "kernel_launch: cooperative launch failed: %s (grid %d)\n", hipGetErrorString(e), grid); } }
#else
    for (int p = 0; p < NPHASE; ++p) { a.ph_lo = p; a.ph_hi = p + 1; hipLaunchKernelGGL(mk_fwd, dim3(grid), dim3(NWAVES * 64), LDS_BYTES, stream, a); }
#endif
}
```

```cpp
#include <hip/hip_runtime.h>
#include <cstdio>
#include <cstdint>
namespace pg8 {
#define PG8_LAS __attribute__((address_space(3)))
typedef unsigned short bf16_t;
typedef short bf16x8 __attribute__((ext_vector_type(8)));
typedef float f32x4 __attribute__((ext_vector_type(4)));
typedef unsigned u32x4 __attribute__((ext_vector_type(4)));
constexpr int BM = 256, BK = 64, HALF = 128, HTB = HALF * BK * 2  , STAGE_BYTES = 8 * HTB, NXCD = 8, WGM = 8;

__host__ __device__ __forceinline__ int lds_byte(int r, int c) { const int st = (r >> 4) * 2 + (c >> 5), rr = r & 15, cc = c & 31, ob = rr * 64 + cc * 2; return st * 1024 + (ob ^ (((ob >> 9) & 1) << 5)); }
__host__ __device__ __forceinline__ void stage_rc(int b, int& R, int& C) { const int st = b / 1024, sb = b % 1024, swz = sb ^ (((sb >> 9) & 1) << 5); R = (st >> 1) * 16 + swz / 64; C = (st & 1) * 32 + (swz % 64) / 2; }
__host__ __device__ __forceinline__ int perm32(int rho) { const int n = rho >> 4, i = rho & 15; return 8 * (i >> 2) + 4 * n + (i & 3); }

struct Unit { int pm, pn; };
struct Gemm { const bf16_t* A; const bf16_t* Bt; int M, N, K; };

struct StaticOrder {
    int nM, nN, nwg, G, c;
    __host__ __device__ void init(int M, int N, int G_, int c_) { nM = M / BM; nN = N / BM; nwg = nM * nN; G = G_; c = c_; }
    __host__ __device__ bool next(int i, Unit& u) const {
        const long L = (long)i * G + c; if (L >= nwg) return false;
        int wgid = (int)L; { const int q = nwg / NXCD, r = nwg % NXCD, xcd = wgid % NXCD, off = wgid / NXCD; wgid = (xcd < r ? xcd * (q + 1) : r * (q + 1) + (xcd - r) * q) + off; }
        const int nig = WGM * nN, gid = wgid / nig, fm = gid * WGM, gsz = (nM - fm) < WGM ? (nM - fm) : WGM;
        u.pm = fm + ((wgid % nig) % gsz); u.pn = (wgid % nig) / gsz; return true;
    }
    __device__ __forceinline__ void a_ready(const Unit&) const {}
    __device__ __forceinline__ void done(const Unit&) const {}
};

__device__ __forceinline__ unsigned cvt_pk_bf16(float lo, float hi) { unsigned r; asm volatile("v_cvt_pk_bf16_f32 %0, %1, %2" : "=v"(r) : "v"(lo), "v"(hi)); return r; }
template <class Epi, class Sched, bool ALIGN_EPI = false, bool SP2 = false>
__device__ __forceinline__ void gemm_phase(PG8_LAS unsigned char* lds, const Gemm g, const Sched& S, const Epi& E, const unsigned* zero_word) {
    int tid_ = (int)(threadIdx.x | *(volatile __attribute__((address_space(1))) unsigned*)zero_word);
    const int tid = tid_, wid = __builtin_amdgcn_readfirstlane(tid >> 6), lane = tid & 63, wr = wid >> 2, wc = wid & 3, fr = lane & 15, fq = lane >> 4;
    const int K = g.K, nt = K / BK;
    unsigned voffA[2], voffB[2];
#pragma unroll
    for (int i = 0; i < 2; ++i) { int R, C; stage_rc(tid * 16 + i * 8192, R, C); const int Rb = Epi::PERM ? ((R & ~31) + perm32(R & 31)) : R;
        voffA[i] = (unsigned)(R * K + C) * 2u; voffB[i] = (unsigned)(Rb * K + C) * 2u; }
    const size_t kstep = (size_t)(BK * 2);
    const size_t hstep = (size_t)HALF * K * 2;
    const size_t tstep = 2 * hstep;
    const unsigned ldsw = (unsigned)wid * 1024u;
    const int aoff = lds_byte(wr * 64 + fr, fq * 8), boff = lds_byte(wc * 32 + fr, fq * 8);
#define PG8_SA(b, h) (((b) * 2 + (h)) * HTB)
#define PG8_SB(b, h) ((4 + (b) * 2 + (h)) * HTB)
#define PG8_STAGE(bufoff, gbase, voff) do { _Pragma("unroll") for (int _i = 0; _i < 2; ++_i) \
        __builtin_amdgcn_global_load_lds((const unsigned*)((const char*)(gbase) + (voff)[_i]), (PG8_LAS unsigned*)(lds + (bufoff) + ldsw + _i * 8192), 16, 0, 0); } while (0)
#define PG8_LDA(dst, b, h) do { _Pragma("unroll") for (int m = 0; m < 4; ++m) _Pragma("unroll") for (int k = 0; k < 2; ++k) dst[m][k] = *(const PG8_LAS bf16x8*)(lds + PG8_SA(b, h) + aoff + m * 2048 + k * 1024); } while (0)
#define PG8_LDB(dst, b, h) do { _Pragma("unroll") for (int n = 0; n < 2; ++n) _Pragma("unroll") for (int k = 0; k < 2; ++k) dst[n][k] = *(const PG8_LAS bf16x8*)(lds + PG8_SB(b, h) + boff + n * 2048 + k * 1024); } while (0)
#define PG8_MMA(ai, bj, At, Bt) do { __builtin_amdgcn_s_setprio(1); _Pragma("unroll") for (int m = 0; m < 4; ++m) _Pragma("unroll") for (int n = 0; n < 2; ++n) _Pragma("unroll") for (int k = 0; k < 2; ++k) \
        acc[ai][bj][m][n] = __builtin_amdgcn_mfma_f32_16x16x32_bf16(Bt[n][k], At[m][k], acc[ai][bj][m][n], 0, 0, 0); __builtin_amdgcn_s_setprio(0); } while (0)
#define PG8_WAIT_V(n) asm volatile("s_waitcnt vmcnt(" #n ")" ::: "memory")
#define PG8_WAIT_L(n) asm volatile("s_waitcnt lgkmcnt(" #n ")" ::: "memory")
#define PG8_BAR __builtin_amdgcn_s_barrier()
#define PG8_SCHED __builtin_amdgcn_sched_barrier(0)
    Unit cur, nxt; int ui = 0;
    if (!S.next(0, cur)) return;
    f32x4 acc[2][2][4][2];
#pragma unroll
    for (int a = 0; a < 2; ++a)
#pragma unroll
        for (int b = 0; b < 2; ++b)
#pragma unroll
            for (int m = 0; m < 4; ++m)
#pragma unroll
                for (int n = 0; n < 2; ++n) acc[a][b][m][n] = (f32x4){0.f, 0.f, 0.f, 0.f};
    bf16x8 At[4][2], B0[2][2], B1[2][2];
    const char* cA = (const char*)g.A + (size_t)cur.pm * tstep; const char* cB = (const char*)g.Bt + (size_t)cur.pn * tstep;
    S.a_ready(cur);
    if constexpr (SP2) {
        PG8_STAGE(PG8_SB(0, 0), cB, voffB); PG8_STAGE(PG8_SB(0, 1), cB + hstep, voffB); PG8_STAGE(PG8_SA(0, 0), cA, voffA); PG8_STAGE(PG8_SA(0, 1), cA + hstep, voffA);
        if (wr == 1) PG8_BAR;
        PG8_WAIT_V(2); PG8_BAR;
        PG8_STAGE(PG8_SB(1, 0), cB + kstep, voffB); PG8_STAGE(PG8_SA(1, 0), cA + kstep, voffA); PG8_STAGE(PG8_SB(1, 1), cB + hstep + kstep, voffB);
        PG8_WAIT_V(6); PG8_BAR;
    } else {
        PG8_STAGE(PG8_SB(0, 0), cB, voffB); PG8_STAGE(PG8_SA(0, 0), cA, voffA); PG8_STAGE(PG8_SB(0, 1), cB + hstep, voffB); PG8_STAGE(PG8_SA(0, 1), cA + hstep, voffA);
        if (wr == 1) PG8_BAR;
        PG8_WAIT_V(4); PG8_BAR;
        PG8_STAGE(PG8_SB(1, 0), cB + kstep, voffB); PG8_STAGE(PG8_SA(1, 0), cA + kstep, voffA); PG8_STAGE(PG8_SB(1, 1), cB + hstep + kstep, voffB);
        PG8_WAIT_V(6); PG8_BAR;
    }
    for (;;) {
        const bool has_next = S.next(ui + 1, nxt);
        const char* nA = has_next ? (const char*)g.A + (size_t)nxt.pm * tstep : cA; const char* nB = has_next ? (const char*)g.Bt + (size_t)nxt.pn * tstep : cB;
_Pragma("nounroll")
        for (int t = 0; t < nt; t += 2) {
            const bool last = (t == nt - 2);
            const char* a1 = cA + (size_t)(t + 1) * kstep;
            const char* a2 = last ? nA : cA + (size_t)(t + 2) * kstep; const char* b2 = last ? nB : cB + (size_t)(t + 2) * kstep;
            const char* a3 = a2 + kstep; const char* b3 = b2 + kstep;
            if (last && has_next) S.a_ready(nxt);
            if constexpr (SP2) {
            PG8_LDB(B0, 0, 0); PG8_LDB(B1, 0, 1); PG8_SCHED; PG8_LDA(At, 0, 0); PG8_STAGE(PG8_SA(1, 1), a1 + hstep, voffA);
            PG8_WAIT_V(8); PG8_WAIT_L(0); PG8_BAR; PG8_MMA(0, 0, At, B0); PG8_MMA(0, 1, At, B1); PG8_BAR; PG8_SCHED;
            PG8_LDA(At, 0, 1); PG8_STAGE(PG8_SB(0, 0), b2, voffB); PG8_STAGE(PG8_SB(0, 1), b2 + hstep, voffB); PG8_STAGE(PG8_SA(0, 0), a2, voffA);
            PG8_WAIT_V(8); PG8_WAIT_L(0); PG8_BAR; PG8_MMA(1, 0, At, B0); PG8_MMA(1, 1, At, B1); PG8_BAR; PG8_SCHED;
            PG8_LDB(B0, 1, 0); PG8_LDB(B1, 1, 1); PG8_SCHED; PG8_LDA(At, 1, 0); PG8_STAGE(PG8_SA(0, 1), a2 + hstep, voffA);
            PG8_WAIT_V(8); PG8_WAIT_L(0); PG8_BAR; PG8_MMA(0, 0, At, B0); PG8_MMA(0, 1, At, B1); PG8_BAR; PG8_SCHED;
            PG8_LDA(At, 1, 1); PG8_STAGE(PG8_SB(1, 0), b3, voffB); PG8_STAGE(PG8_SB(1, 1), b3 + hstep, voffB); PG8_STAGE(PG8_SA(1, 0), a3, voffA);
            PG8_WAIT_V(8); PG8_WAIT_L(0); PG8_BAR; PG8_MMA(1, 0, At, B0); PG8_MMA(1, 1, At, B1); PG8_BAR; PG8_SCHED;
            } else {
            PG8_LDB(B0, 0, 0); PG8_SCHED; PG8_LDA(At, 0, 0); PG8_STAGE(PG8_SA(1, 1), a1 + hstep, voffA);
            PG8_WAIT_L(8); PG8_BAR; PG8_WAIT_L(0); PG8_MMA(0, 0, At, B0); PG8_BAR; PG8_SCHED;
            PG8_LDB(B1, 0, 1); PG8_STAGE(PG8_SB(0, 0), b2, voffB);
            PG8_BAR; PG8_WAIT_L(0); PG8_MMA(0, 1, At, B1); PG8_BAR;
            PG8_LDA(At, 0, 1); PG8_STAGE(PG8_SA(0, 0), a2, voffA);
            PG8_BAR; PG8_WAIT_L(0); PG8_MMA(1, 0, At, B0); PG8_BAR; PG8_SCHED;
            PG8_STAGE(PG8_SB(0, 1), b2 + hstep, voffB);
            PG8_WAIT_V(6); PG8_BAR; PG8_MMA(1, 1, At, B1); PG8_BAR;
            PG8_LDB(B0, 1, 0); PG8_SCHED; PG8_LDA(At, 1, 0); PG8_STAGE(PG8_SA(0, 1), a2 + hstep, voffA);
            PG8_WAIT_L(8); PG8_BAR; PG8_WAIT_L(0); PG8_MMA(0, 0, At, B0); PG8_BAR; PG8_SCHED;
            PG8_LDB(B1, 1, 1); PG8_STAGE(PG8_SB(1, 0), b3, voffB);
            PG8_BAR; PG8_WAIT_L(0); PG8_MMA(0, 1, At, B1); PG8_BAR;
            PG8_LDA(At, 1, 1); PG8_STAGE(PG8_SA(1, 0), a3, voffA);
            PG8_BAR; PG8_WAIT_L(0); PG8_MMA(1, 0, At, B0); PG8_BAR; PG8_SCHED;
            PG8_STAGE(PG8_SB(1, 1), b3 + hstep, voffB);
            PG8_WAIT_V(6); PG8_BAR; PG8_MMA(1, 1, At, B1); PG8_BAR;
            }
        }
        if constexpr (ALIGN_EPI) { if (wr == 0) PG8_BAR; }
        if constexpr (!Epi::AFTER_DRAIN) { E(acc, cur, wr, wc, fr, fq); S.done(cur); }
        if (!has_next) break;
#pragma unroll
        for (int a = 0; a < 2; ++a)
#pragma unroll
            for (int b = 0; b < 2; ++b)
#pragma unroll
                for (int m = 0; m < 4; ++m)
#pragma unroll
                    for (int n = 0; n < 2; ++n) acc[a][b][m][n] = (f32x4){0.f, 0.f, 0.f, 0.f};
        cur = nxt; cA = nA; cB = nB; ++ui;
        if constexpr (ALIGN_EPI) { if (wr == 1) PG8_BAR; }
    }
    PG8_WAIT_V(0);
    if constexpr (!ALIGN_EPI) { if (wr == 0) PG8_BAR; }
    PG8_BAR;
    if constexpr (Epi::AFTER_DRAIN) { E.fused(acc, cur, wr, wc, fr, fq, lds, wid, lane); S.done(cur); }
#undef PG8_SA
#undef PG8_SB
#undef PG8_STAGE
#undef PG8_LDA
#undef PG8_LDB
#undef PG8_MMA
#undef PG8_WAIT_V
#undef PG8_WAIT_L
#undef PG8_BAR
#undef PG8_SCHED
}
}

template <class F> struct EpiRow {
    static constexpr bool PERM = true, AFTER_DRAIN = false;
    F f;
    __device__ __forceinline__ void operator()(const pg8::f32x4 (&acc)[2][2][4][2], const pg8::Unit& u, int wr, int wc, int fr, int fq) const {
        const int rowb = u.pm * 256 + wr * 64 + fr, cb = wc * 32 + 8 * fq;
#pragma unroll
        for (int ai = 0; ai < 2; ++ai)
#pragma unroll
            for (int m = 0; m < 4; ++m) { f(rowb + ai * 128 + m * 16, u.pn, cb, acc[ai][0][m][0], acc[ai][0][m][1], acc[ai][1][m][0], acc[ai][1][m][1]); if (m & 1) asm volatile("" ::: "memory"); }
    }
};

#define GAS __attribute__((address_space(1)))
#define LAS __attribute__((address_space(3)))
typedef unsigned short bf16;
typedef unsigned v4u __attribute__((ext_vector_type(4)));
typedef unsigned v2u __attribute__((ext_vector_type(2)));
typedef float f32x4 __attribute__((ext_vector_type(4)));
typedef float f32x16 __attribute__((ext_vector_type(16)));
typedef short bf16x8 __attribute__((ext_vector_type(8)));
typedef short s16x4 __attribute__((ext_vector_type(4)));
typedef GAS unsigned gu32;
typedef GAS unsigned long long gu64;
#define RLX_AGENT __ATOMIC_RELAXED, __HIP_MEMORY_SCOPE_AGENT
#define LDS_WAIT() asm volatile("s_waitcnt lgkmcnt(0)" ::: "memory")
#define VM_WAIT() asm volatile("s_waitcnt vmcnt(0)" ::: "memory")
__device__ __forceinline__ unsigned f2bf(float f) { unsigned u = __builtin_bit_cast(unsigned, f); return (u + 0x7fffu + ((u >> 16) & 1u)) >> 16; }
__device__ __forceinline__ unsigned pk2(float lo, float hi) { return f2bf(lo) | (f2bf(hi) << 16); }
__device__ __forceinline__ float bf2f(unsigned short b) { return __builtin_bit_cast(float, (unsigned)b << 16); }
__device__ __forceinline__ unsigned cvtpk(float lo, float hi) { return pg8::cvt_pk_bf16(lo, hi); }
__device__ __forceinline__ v4u pack8(f32x4 a, f32x4 b) { v4u w; w.x = cvtpk(a[0], a[1]); w.y = cvtpk(a[2], a[3]); w.z = cvtpk(b[0], b[1]); w.w = cvtpk(b[2], b[3]); return w; }
__device__ __forceinline__ void unpack8(v4u w, f32x4& a, f32x4& b) {
    a[0] = __builtin_bit_cast(float, w.x << 16); a[1] = __builtin_bit_cast(float, w.x & 0xffff0000u); a[2] = __builtin_bit_cast(float, w.y << 16); a[3] = __builtin_bit_cast(float, w.y & 0xffff0000u);
    b[0] = __builtin_bit_cast(float, w.z << 16); b[1] = __builtin_bit_cast(float, w.z & 0xffff0000u); b[2] = __builtin_bit_cast(float, w.w << 16); b[3] = __builtin_bit_cast(float, w.w & 0xffff0000u); }
__device__ __forceinline__ float fexp2(float x) { return __builtin_amdgcn_exp2f(x); }
__device__ __forceinline__ float frcp(float x) { return __builtin_amdgcn_rcpf(x); }
__device__ __forceinline__ float sigmoidf_(float x) { return frcp(1.0f + fexp2(-1.4426950408889634f * x)); }
#define XB_TMO      128
#define XB_XCNT(j)  (256  + 64 * (j))
#define XB_XSUB(j)  (1280 + 64 * (j))
#define XB_XGEN(j)  (2304 + 64 * (j))
#define XB_TOP      3328
#define XB_TOPGEN   3392
#define XCD_BAR_WORDS 3456
#define XB_SPIN_CAP (1u << 18)

__device__ __forceinline__ unsigned xb_ld(unsigned* p)              { return __hip_atomic_load(p, __ATOMIC_RELAXED, __HIP_MEMORY_SCOPE_AGENT); }
__device__ __forceinline__ unsigned xb_add(unsigned* p, unsigned v) { return __hip_atomic_fetch_add(p, v, __ATOMIC_RELAXED, __HIP_MEMORY_SCOPE_AGENT); }
__device__ __forceinline__ unsigned xb_xcc_id() { return (unsigned)__builtin_amdgcn_s_getreg((3 << 11) | 20) & 0xFu; }
#define XB_SPIN(cond, bar) do { unsigned _sp = 0; while (cond) { __builtin_amdgcn_s_sleep(1); \
    if ((++_sp & 255u) == 0u) { if (xb_ld(&(bar)[XB_TMO])) break; if (_sp > XB_SPIN_CAP) { atomicAdd(&(bar)[XB_TMO], 1u); break; } } } } while (0)

struct XcdBarrier {
    unsigned* bar; unsigned x;
    volatile LAS unsigned* st;
};

__device__ __forceinline__ XcdBarrier xcd_barrier_post(unsigned* bar, volatile LAS unsigned* st) {
    XcdBarrier b; b.bar = bar; b.x = xb_xcc_id(); b.st = st;
    if (threadIdx.x == 0) (void)xb_add(&bar[XB_XCNT(b.x)], 1u);
    return b;
}
__device__ __forceinline__ void xcd_barrier_complete(unsigned* bar, unsigned x, unsigned& nloc, unsigned& nx) {
    const unsigned G = gridDim.x * gridDim.y * gridDim.z;
    unsigned sum, cnt, mine, sp = 0u;
    for (;;) {
        sum = 0u; cnt = 0u; mine = 0u;
#pragma unroll
        for (unsigned j = 0; j < 16; ++j) { const unsigned c = xb_ld(&bar[XB_XCNT(j)]); sum += c; cnt += (c > 0u) ? 1u : 0u; mine = (j == x) ? c : mine; }
        if (sum == G) break;
        __builtin_amdgcn_s_sleep(1);
        if ((++sp & 255u) == 0u) { if (xb_ld(&bar[XB_TMO])) break; if (sp > XB_SPIN_CAP) { atomicAdd(&bar[XB_TMO], 1u); break; } }
    }
    nloc = mine > 0u ? mine : 1u; nx = cnt > 0u ? cnt : 1u;
}

__device__ __forceinline__ void xcd_barrier(const XcdBarrier& b) {
    asm volatile("s_waitcnt vmcnt(0)" ::: "memory");
    __syncthreads();
    if (threadIdx.x == 0) {
        unsigned* bar = b.bar;
        __builtin_amdgcn_s_waitcnt(0);
        unsigned nloc = b.st[0], nx = b.st[1];
        if (nloc == 0u) { xcd_barrier_complete(bar, b.x, nloc, nx); b.st[0] = nloc; b.st[1] = nx; }
        const unsigned old = xb_add(&bar[XB_XSUB(b.x)], 1u);
        const unsigned gen = old / nloc;
        if (old + 1u == (gen + 1u) * nloc) {
            __builtin_amdgcn_fence(__ATOMIC_RELEASE, "agent");
            asm volatile("s_waitcnt vmcnt(0)" ::: "memory");
            const unsigned og = xb_add(&bar[XB_TOP], 1u);
            const unsigned tg = og / nx;
            if (og + 1u == (tg + 1u) * nx) xb_add(&bar[XB_TOPGEN], 1u);
            else XB_SPIN(xb_ld(&bar[XB_TOPGEN]) == tg, bar);
            __builtin_amdgcn_fence(__ATOMIC_ACQUIRE, "agent");
            xb_add(&bar[XB_XGEN(b.x)], 1u);
            asm volatile("s_waitcnt vmcnt(0)" ::: "memory");
        } else {
            XB_SPIN(xb_ld(&bar[XB_XGEN(b.x)]) == gen, bar);
            __builtin_amdgcn_fence(__ATOMIC_ACQUIRE, "agent");
            asm volatile("s_waitcnt vmcnt(0)" ::: "memory");
        }
    }
    __syncthreads();
}

constexpr int NWAVES = 8;
#ifndef MK_ONE_LAUNCH
#define MK_ONE_LAUNCH 1
#endif
constexpr int BATCH = 16, SEQ = 2048, D = 1024, M = BATCH * SEQ, FF = 2816, MEML = 256, MM = BATCH * MEML;
constexpr int NPROJ = 2304, NPG = NPROJ + 2048;
constexpr int QR = 384, KVR = 256;
constexpr float LN_EPS = 1e-5f, RMS_EPS = 1e-6f;
constexpr float ALPHA = 1.189207115002721f;
constexpr float LOG2E = 1.4426950408889634f;
constexpr float C2_MLA = 0.10206207261596577f * LOG2E;
constexpr float C2_DIFF = 0.125f * LOG2E;
constexpr float C2_MEM = 0.0625f * LOG2E;
constexpr float LAM_INIT = 0.2f;
constexpr int NPHASE = 17;
enum { PH_PRO = 0, PH_FFN1UP, PH_FFN1DN, PH_LN1, PH_PROJ, PH_QKVUP, PH_ATTN, PH_YG, PH_WO, PH_LN2, PH_MEMQ, PH_MEMATT, PH_MEMO, PH_LN3, PH_FFN2UP, PH_FFN2DN, PH_LN4 };

constexpr size_t MiB = 1u << 20;
constexpr size_t WS_CTL = 0, CTL_ZERO_BYTES = 1 * MiB;
constexpr size_t WS_W1C1 = 1 * MiB, WS_W21 = 12 * MiB, WS_W1C2 = 18 * MiB, WS_W22 = 29 * MiB, WS_WPG = 35 * MiB, WS_WQB = 44 * MiB, WS_WKVB = 45 * MiB, WS_WY = 46 * MiB,
                 WS_WO = 50 * MiB, WS_WMQ = 52 * MiB, WS_WMKV = 54 * MiB, WS_WMO = 58 * MiB;
constexpr size_t WS_TAB = 60 * MiB;
constexpr size_t WS_SSQQ = 61 * MiB, WS_SSQKV = 62 * MiB;
constexpr size_t WS_KVM = 63 * MiB;
constexpr size_t WS_HF = 80 * MiB;
constexpr size_t WS_HB = 208 * MiB;
constexpr size_t WS_U = 272 * MiB;
constexpr size_t WS_G = 272 * MiB, WS_QM = 272 * MiB, WS_OMEM = 336 * MiB;
constexpr size_t WS_QD = 400 * MiB, WS_KD = 432 * MiB, WS_VD = 464 * MiB;
constexpr size_t WS_KROPE = 496 * MiB, WS_MEMB = 498 * MiB, WS_END = 512 * MiB;
constexpr size_t OUT_CQ = 0, OUT_CKV = 24 * MiB, OUT_QMLA = 80 * MiB, OUT_OMD = 0;
constexpr int CW_BAR = 4096;

constexpr int RING_OFF = 0, RING_BYTES = 131072;
constexpr int LDSCTL_OFF = RING_BYTES, MISC_OFF = LDSCTL_OFF + 320;
constexpr int LDS_BYTES = 147456;

__device__ __forceinline__ float wave_sum(float v) {
#pragma unroll
    for (int o = 1; o < 64; o <<= 1) v += __shfl_xor(v, o);
    return v;
}

__device__ __forceinline__ int ropepos(int i) { return i < 16 ? 8 * (i >> 2) + (i & 3) : 8 * ((i - 16) >> 2) + 4 + (i & 3); }
template <int MODE> __device__ __forceinline__ int rowmap(int n) {
    if constexpr (MODE == 0) return n;
    else if constexpr (MODE == 1) return 256 * (n >> 7) + (n & 127);
    else if constexpr (MODE == 2) return 256 * (n >> 7) + 128 + (n & 127);
    else if constexpr (MODE == 3) {
        if (n < 384) return n; if (n < 640) return 512 + (n - 384); if (n < 672) return 384 + ropepos(n - 640);
        if (n < 1184) return 768 + (n - 672); if (n < 1696) return 1280 + (n - 1184); return 1792 + (n - 1696); }
    else if constexpr (MODE == 4) return NPROJ + n;
    else if constexpr (MODE == 5) { const int h = n / 96, j = n - 96 * h; return j < 64 ? n : 96 * h + 64 + ropepos(j - 64); }
    else { const int h = n >> 7, j = n & 127; return j < 64 ? 64 * h + j : 512 + 64 * h + (j - 64); }
}
template <int MODE> __device__ __forceinline__ void p0_tr_item(const float* W, int K, int N, bf16* WT, int ldk, int koff, const float* kscale, LAS float* scr, int item, int lane) {
    const int nblk = N / 32, kb = item / nblk, nb = item % nblk, k0 = 64 * kb, n0 = 32 * nb;
#pragma unroll 8
    for (int i = 0; i < 32; ++i) { const int kk = 2 * i + (lane >> 5); float v = W[(size_t)(k0 + kk) * N + n0 + (lane & 31)]; if (kscale) v *= kscale[k0 + kk]; scr[kk * 33 + (lane & 31)] = v; }
    LDS_WAIT(); asm volatile("" ::: "memory");
    const int c = lane & 7;
#pragma unroll
    for (int j = 0; j < 4; ++j) { const int n = (lane >> 3) + 8 * j; const LAS float* s = scr + (8 * c) * 33 + n;
        v4u o; o.x = pk2(s[0 * 33], s[1 * 33]); o.y = pk2(s[2 * 33], s[3 * 33]); o.z = pk2(s[4 * 33], s[5 * 33]); o.w = pk2(s[6 * 33], s[7 * 33]);
        *(GAS v4u*)(WT + (size_t)rowmap<MODE>(n0 + n) * ldk + koff + k0 + 8 * c) = o; }
    LDS_WAIT(); asm volatile("" ::: "memory");
}

struct Ptrs {
    const float* in[35]; float* out; unsigned char* ws;
};
#define IN_X 0
#define IN_MEM 1
#define IN_RELB 2
#define IN_F1W1 3
#define IN_F1W3 4
#define IN_F1W2 5
#define IN_LN1G 6
#define IN_LN1B 7
#define IN_WIN 8
#define IN_QNG 9
#define IN_KVNG 10
#define IN_WQB 11
#define IN_WKVB 12
#define IN_LQ1 13
#define IN_LK1 14
#define IN_LQ2 15
#define IN_LK2 16
#define IN_DNG 17
#define IN_WGATE 18
#define IN_BGATE 19
#define IN_WUM 20
#define IN_WUD 21
#define IN_WOUT 22
#define IN_LN2G 23
#define IN_LN2B 24
#define IN_MWQ 25
#define IN_MWKV 26
#define IN_MWO 27
#define IN_LN3G 28
#define IN_LN3B 29
#define IN_F2W1 30
#define IN_F2W3 31
#define IN_F2W2 32
#define IN_LN4G 33
#define IN_LN4B 34

__device__ __forceinline__ void p0_prologue(const float* const* in, unsigned char* ws, LAS unsigned char* lds, int vcu, int G, int wave, int lane, int tid) {
    LAS float* scr = (LAS float*)(lds + RING_OFF + wave * 16384);
    const int gw = vcu * NWAVES + wave, NGW = G * NWAVES;
    constexpr int I_UP = (D / 64) * (FF / 32), I_DN = (FF / 64) * (D / 32), I_IN = (D / 64) * (2208 / 32), I_G = (D / 64) * (2048 / 32), I_QB = (QR / 64) * (768 / 32), I_KVB = (KVR / 64) * (1024 / 32),
                  I_Y = (512 / 64) * (D / 32), I_SQ = (D / 64) * (D / 32), I_MKV = (D / 64) * (2048 / 32);
    constexpr int NITEMS = 4 * I_UP + 2 * I_DN + I_IN + I_G + I_QB + I_KVB + 2 * I_Y + 3 * I_SQ + I_MKV;
    for (int it = gw; it < NITEMS; it += NGW) {
        int r = it;
        if (r < I_UP) { p0_tr_item<1>(in[IN_F1W1], D, FF, (bf16*)(ws + WS_W1C1), D, 0, nullptr, scr, r, lane); continue; } r -= I_UP;
        if (r < I_UP) { p0_tr_item<2>(in[IN_F1W3], D, FF, (bf16*)(ws + WS_W1C1), D, 0, nullptr, scr, r, lane); continue; } r -= I_UP;
        if (r < I_DN) { p0_tr_item<0>(in[IN_F1W2], FF, D, (bf16*)(ws + WS_W21), FF, 0, nullptr, scr, r, lane); continue; } r -= I_DN;
        if (r < I_UP) { p0_tr_item<1>(in[IN_F2W1], D, FF, (bf16*)(ws + WS_W1C2), D, 0, nullptr, scr, r, lane); continue; } r -= I_UP;
        if (r < I_UP) { p0_tr_item<2>(in[IN_F2W3], D, FF, (bf16*)(ws + WS_W1C2), D, 0, nullptr, scr, r, lane); continue; } r -= I_UP;
        if (r < I_DN) { p0_tr_item<0>(in[IN_F2W2], FF, D, (bf16*)(ws + WS_W22), FF, 0, nullptr, scr, r, lane); continue; } r -= I_DN;
        if (r < I_IN) { p0_tr_item<3>(in[IN_WIN], D, 2208, (bf16*)(ws + WS_WPG), D, 0, nullptr, scr, r, lane); continue; } r -= I_IN;
        if (r < I_G) { p0_tr_item<4>(in[IN_WGATE], D, 2048, (bf16*)(ws + WS_WPG), D, 0, nullptr, scr, r, lane); continue; } r -= I_G;
        if (r < I_QB) { p0_tr_item<5>(in[IN_WQB], QR, 768, (bf16*)(ws + WS_WQB), QR, 0, in[IN_QNG], scr, r, lane); continue; } r -= I_QB;
        if (r < I_KVB) { p0_tr_item<6>(in[IN_WKVB], KVR, 1024, (bf16*)(ws + WS_WKVB), KVR, 0, in[IN_KVNG], scr, r, lane); continue; } r -= I_KVB;
        if (r < I_Y) { p0_tr_item<1>(in[IN_WUM], 512, D, (bf16*)(ws + WS_WY), D, 0, nullptr, scr, r, lane); continue; } r -= I_Y;
        if (r < I_Y) { p0_tr_item<2>(in[IN_WUD], 512, D, (bf16*)(ws + WS_WY), D, 512, nullptr, scr, r, lane); continue; } r -= I_Y;
        if (r < I_SQ) { p0_tr_item<0>(in[IN_WOUT], D, D, (bf16*)(ws + WS_WO), D, 0, nullptr, scr, r, lane); continue; } r -= I_SQ;
        if (r < I_SQ) { p0_tr_item<0>(in[IN_MWQ], D, D, (bf16*)(ws + WS_WMQ), D, 0, nullptr, scr, r, lane); continue; } r -= I_SQ;
        if (r < I_MKV) { p0_tr_item<0>(in[IN_MWKV], D, 2048, (bf16*)(ws + WS_WMKV), D, 0, nullptr, scr, r, lane); continue; } r -= I_MKV;
        p0_tr_item<0>(in[IN_MWO], D, D, (bf16*)(ws + WS_WMO), D, 0, nullptr, scr, r, lane);
    }
    const int gt = vcu * (NWAVES * 64) + tid, NGT = G * NWAVES * 64;
    const v4u zero4 = {0u, 0u, 0u, 0u};
    for (int i = gt; i < 2048 * 64; i += NGT) { const int row = i >> 6, ch = i & 63; *(GAS v4u*)((bf16*)(ws + WS_WY) + (size_t)row * D + ((row & 128) ? 0 : 512) + ch * 8) = zero4; }
    for (int i = gt; i < 96 * 128; i += NGT) { const int row = 416 + (i >> 7), ch = i & 127; *(GAS v4u*)((bf16*)(ws + WS_WPG) + (size_t)row * D + ch * 8) = zero4; }
    { const GAS f32x4* x4 = (const GAS f32x4*)in[IN_X]; GAS v4u* o = (GAS v4u*)(ws + WS_HB);
      for (int i = gt; i < M * D / 8; i += NGT) { const f32x4 a = x4[2 * i], b = x4[2 * i + 1]; o[i] = pack8(a, b); }
      const GAS f32x4* m4 = (const GAS f32x4*)in[IN_MEM]; GAS v4u* om = (GAS v4u*)(ws + WS_MEMB);
      for (int i = gt; i < MM * D / 8; i += NGT) { const f32x4 a = m4[2 * i], b = m4[2 * i + 1]; om[i] = pack8(a, b); } }
    { float* tab = (float*)(ws + WS_TAB);
      for (int i = gt; i < SEQ * 16; i += NGT) { const int pos = i >> 4, k = i & 15;
          const double fr[16] = {1.0, 0.5623413251903491, 0.31622776601683794, 0.1778279410038923, 0.1, 0.05623413251903491, 0.03162277660168379, 0.01778279410038923, 0.01, 0.005623413251903491,
                                 0.0031622776601683794, 0.0017782794100389228, 0.001, 0.0005623413251903491, 0.00031622776601683794, 0.00017782794100389227};
          double f = 1.0;
#pragma unroll
          for (int q = 0; q < 16; ++q) f = (k == q) ? fr[q] : f;
          const double t = (double)pos * f * 0.15915494309189535;
          const float frac = (float)(t - __builtin_floor(t));
          tab[2 * i] = __builtin_amdgcn_cosf(frac); tab[2 * i + 1] = __builtin_amdgcn_sinf(frac); }
      float* bt = (float*)(ws + WS_TAB + 256 * 1024);
      for (int i = gt; i < 8 * 128; i += NGT) { const int mp = i >> 7, n = i & 127;
          int bk = n; if (n >= 16) { bk = 16 + (int)(__builtin_amdgcn_logf((float)n * 0.0625f) * (16.0f / 3.0f)); bk = bk > 31 ? 31 : bk; }
          bt[i] = (in[IN_RELB][bk * 8 + mp] - in[IN_RELB][31 * 8 + mp]) * LOG2E; }
      if (gt < 64) { const float a = in[IN_LQ1][gt] * in[IN_LK1][gt], b = in[IN_LQ2][gt] * in[IN_LK2][gt]; const float s1 = wave_sum(a), s2 = wave_sum(b);
          if (gt == 0) ((float*)(ws + WS_TAB + 260 * 1024))[0] = fexp2(s1 * LOG2E) - fexp2(s2 * LOG2E) + LAM_INIT; } }
}

__device__ __forceinline__ void ln_rows(const float* Z, const float* g, const float* b, float* HF, bf16* HB, int gw, int NGW, int lane) {
    f32x4 gv[4], bv[4];
#pragma unroll
    for (int j = 0; j < 4; ++j) { gv[j] = ((const GAS f32x4*)g)[lane + 64 * j]; bv[j] = ((const GAS f32x4*)b)[lane + 64 * j]; }
    for (int m = gw; m < M; m += NGW) {
        const GAS f32x4* xr = (const GAS f32x4*)(Z + (size_t)m * D) + lane;
        f32x4 v[4]; float s = 0.f;
#pragma unroll
        for (int j = 0; j < 4; ++j) { v[j] = xr[64 * j]; s += (v[j].x + v[j].y) + (v[j].z + v[j].w); }
        const float mean = wave_sum(s) * (1.f / D); float s2 = 0.f;
#pragma unroll
        for (int j = 0; j < 4; ++j) { v[j] = v[j] - mean; s2 += (v[j].x * v[j].x + v[j].y * v[j].y) + (v[j].z * v[j].z + v[j].w * v[j].w); }
        const float rstd = 1.f / sqrtf(wave_sum(s2) * (1.f / D) + LN_EPS);
        GAS f32x4* of = (GAS f32x4*)(HF + (size_t)m * D) + lane;
#pragma unroll
        for (int j = 0; j < 4; ++j) { v[j] = v[j] * rstd * gv[j] + bv[j]; of[64 * j] = v[j]; }
        if (HB) { GAS v2u* o8 = (GAS v2u*)(HB + (size_t)m * D) + lane;
#pragma unroll
            for (int j = 0; j < 4; ++j) { v2u w; w.x = cvtpk(v[j].x, v[j].y); w.y = cvtpk(v[j].z, v[j].w); o8[64 * j] = w; } }
    }
}

struct FSwiglu {
    bf16* U;
    __device__ __forceinline__ void operator()(int row, int pn, int cb, f32x4 a0, f32x4 a1, f32x4 b0, f32x4 b1) const {
        f32x4 r0, r1;
#pragma unroll
        for (int e = 0; e < 4; ++e) { r0[e] = a0[e] * sigmoidf_(a0[e]) * b0[e]; r1[e] = a1[e] * sigmoidf_(a1[e]) * b1[e]; }
        *(GAS v4u*)(U + (size_t)row * FF + 128 * pn + cb) = pack8(r0, r1);
    }
};
struct FResid {
    const float* base; float* Z; float s;
    __device__ __forceinline__ void operator()(int row, int pn, int cb, f32x4 a0, f32x4 a1, f32x4 b0, f32x4 b1) const {
        const size_t o = (size_t)row * D + 256 * pn + cb;
        const f32x4 x0 = *(const GAS f32x4*)(base + o), x1 = *(const GAS f32x4*)(base + o + 4), y0 = *(const GAS f32x4*)(base + o + 128), y1 = *(const GAS f32x4*)(base + o + 132);
        *(GAS f32x4*)(Z + o) = x0 * ALPHA + a0 * s; *(GAS f32x4*)(Z + o + 4) = x1 * ALPHA + a1 * s;
        *(GAS f32x4*)(Z + o + 128) = y0 * ALPHA + b0 * s; *(GAS f32x4*)(Z + o + 132) = y1 * ALPHA + b1 * s;
    }
};
struct FPlain {
    bf16* O; int ldc; float s;
    __device__ __forceinline__ void operator()(int row, int pn, int cb, f32x4 a0, f32x4 a1, f32x4 b0, f32x4 b1) const {
        bf16* p = O + (size_t)row * ldc + 256 * pn + cb;
        *(GAS v4u*)p = pack8(a0 * s, a1 * s); *(GAS v4u*)(p + 128) = pack8(b0 * s, b1 * s);
    }
};
__device__ __forceinline__ float ssq8(f32x4 a, f32x4 b) { return (a[0] * a[0] + a[1] * a[1]) + (a[2] * a[2] + a[3] * a[3]) + (b[0] * b[0] + b[1] * b[1]) + (b[2] * b[2] + b[3] * b[3]); }
__device__ __forceinline__ float red_fq(float s) { s += __shfl_xor(s, 16); s += __shfl_xor(s, 32); return s; }
__device__ __forceinline__ void rope8(f32x4& x1, f32x4& x2, const float* tabrow, int g) {
    const GAS f32x4* t = (const GAS f32x4*)(tabrow + 8 * g);
    const f32x4 t0 = t[0], t1 = t[1];
    f32x4 o1, o2;
    o1[0] = x1[0] * t0[0] - x2[0] * t0[1]; o2[0] = x2[0] * t0[0] + x1[0] * t0[1];
    o1[1] = x1[1] * t0[2] - x2[1] * t0[3]; o2[1] = x2[1] * t0[2] + x1[1] * t0[3];
    o1[2] = x1[2] * t1[0] - x2[2] * t1[1]; o2[2] = x2[2] * t1[0] + x1[2] * t1[1];
    o1[3] = x1[3] * t1[2] - x2[3] * t1[3]; o2[3] = x2[3] * t1[2] + x1[3] * t1[3];
    x1 = o1; x2 = o2;
}
struct FProj {
    bf16 *CQ, *CKV, *KROPE, *QKVD, *G; float *SSQQ, *SSQKV; const float* bgate; const float* rtab;
    __device__ __forceinline__ void operator()(int row, int pn, int cb, f32x4 a0, f32x4 a1, f32x4 b0, f32x4 b1) const {
        const int wc = cb >> 5, fq = (cb >> 3) & 3;
        if (pn == 0) {
            bf16* p = CQ + (size_t)row * QR + cb; *(GAS v4u*)p = pack8(a0, a1); *(GAS v4u*)(p + 128) = pack8(b0, b1);
            const float s = red_fq(ssq8(a0, a1) + ssq8(b0, b1)); if (fq == 0) SSQQ[(size_t)row * 8 + wc] = s;
        } else if (pn == 1) {
            *(GAS v4u*)(CQ + (size_t)row * QR + 256 + cb) = pack8(a0, a1);
            const float s = red_fq(ssq8(a0, a1)); if (fq == 0) SSQQ[(size_t)row * 8 + 4 + wc] = s;
            if (wc == 0) { rope8(b0, b1, rtab + (size_t)(row & (SEQ - 1)) * 32, fq); *(GAS v4u*)(KROPE + (size_t)row * 32 + cb) = pack8(b0, b1); }
        } else if (pn == 2) {
            bf16* p = CKV + (size_t)row * KVR + cb; *(GAS v4u*)p = pack8(a0, a1); *(GAS v4u*)(p + 128) = pack8(b0, b1);
            const float s = red_fq(ssq8(a0, a1) + ssq8(b0, b1)); if (fq == 0) SSQKV[(size_t)row * 4 + wc] = s;
        } else if (pn < 9) {
            const int t = pn - 3; bf16* base = QKVD + (size_t)(t >> 1) * ((size_t)M * 512); const float sc = t < 2 ? C2_DIFF : 1.0f;
            bf16* p = base + (size_t)row * 512 + 256 * (t & 1) + cb; *(GAS v4u*)p = pack8(a0 * sc, a1 * sc); *(GAS v4u*)(p + 128) = pack8(b0 * sc, b1 * sc);
        } else {
            const int c0 = 256 * (pn - 9) + cb;
            const f32x4 ba0 = *(const GAS f32x4*)(bgate + c0), ba1 = *(const GAS f32x4*)(bgate + c0 + 4), bb0 = *(const GAS f32x4*)(bgate + c0 + 128), bb1 = *(const GAS f32x4*)(bgate + c0 + 132);
            f32x4 r0, r1, r2, r3;
#pragma unroll
            for (int e = 0; e < 4; ++e) { r0[e] = sigmoidf_(a0[e] + ba0[e]); r1[e] = sigmoidf_(a1[e] + ba1[e]); r2[e] = sigmoidf_(b0[e] + bb0[e]); r3[e] = sigmoidf_(b1[e] + bb1[e]); }
            bf16* p = G + (size_t)row * 2048 + c0; *(GAS v4u*)p = pack8(r0, r1); *(GAS v4u*)(p + 128) = pack8(r2, r3);
        }
    }
};
struct FQup {
    bf16* Q; const float* SSQQ; const float* rtab;
    __device__ __forceinline__ void operator()(int row, int pn, int cb, f32x4 a0, f32x4 a1, f32x4 b0, f32x4 b1) const {
        const GAS f32x4* sp = (const GAS f32x4*)(SSQQ + (size_t)row * 8); const f32x4 s0 = sp[0], s1 = sp[1];
        const float ss = ((s0[0] + s0[1]) + (s0[2] + s0[3])) + ((s1[0] + s1[1]) + (s1[2] + s1[3]));
        const float sc = C2_MLA / sqrtf(ss * (1.0f / QR) + RMS_EPS);
        a0 = a0 * sc; a1 = a1 * sc; b0 = b0 * sc; b1 = b1 * sc;
        const float* tr = rtab + (size_t)(row & (SEQ - 1)) * 32;
        const int ca = 256 * pn + cb, cbb = ca + 128;
        { const int j = ca % 96; if (j >= 64) rope8(a0, a1, tr, (j - 64) >> 3); }
        { const int j = cbb % 96; if (j >= 64) rope8(b0, b1, tr, (j - 64) >> 3); }
        *(GAS v4u*)(Q + (size_t)row * 768 + ca) = pack8(a0, a1); *(GAS v4u*)(Q + (size_t)row * 768 + cbb) = pack8(b0, b1); asm volatile("" ::: "memory");
    }
};
struct FKVup {
    bf16* KV; const float* SSQKV;
    __device__ __forceinline__ void operator()(int row, int pn, int cb, f32x4 a0, f32x4 a1, f32x4 b0, f32x4 b1) const {
        const f32x4 s0 = *(const GAS f32x4*)(SSQKV + (size_t)row * 4);
        const float sc = 1.0f / sqrtf(((s0[0] + s0[1]) + (s0[2] + s0[3])) * (1.0f / KVR) + RMS_EPS);
        bf16* p = KV + (size_t)row * 1024 + 256 * pn + cb; *(GAS v4u*)p = pack8(a0 * sc, a1 * sc); *(GAS v4u*)(p + 128) = pack8(b0 * sc, b1 * sc);
    }
};
struct FYGate {
    bf16* MIX; const bf16* G;
    __device__ __forceinline__ void operator()(int row, int pn, int cb, f32x4 a0, f32x4 a1, f32x4 b0, f32x4 b1) const {
        const int c = 128 * pn + cb; f32x4 gm0, gm1, gd0, gd1;
        unpack8(*(const GAS v4u*)(G + (size_t)row * 2048 + c), gm0, gm1); unpack8(*(const GAS v4u*)(G + (size_t)row * 2048 + 1024 + c), gd0, gd1);
        *(GAS v4u*)(MIX + (size_t)row * D + c) = pack8(gm0 * a0 + gd0 * b0, gm1 * a1 + gd1 * b1);
    }
};

__device__ __forceinline__ int crow(int r, int hi) { return (r & 3) + 8 * (r >> 2) + 4 * hi; }
typedef short v4i16_t __attribute__((ext_vector_type(4)));
__device__ __forceinline__ s16x4 vtr(const LAS unsigned char* p) { return __builtin_bit_cast(s16x4, __builtin_amdgcn_ds_read_tr16_b64_v4i16((LAS v4i16_t*)p)); }
constexpr float NEGBIG = -1.0e30f;
constexpr int ATT_WSF_OFF = 53248, ATT_BIAS_OFF = 55296, BIAS_PITCH = 320;
template <int DQK, int DV, int KW1, bool CAUSAL, bool BIAS, bool PF>
__device__ __forceinline__ void attn_core(LAS unsigned char* lds, const bf16* Qp, const bf16* K1, int ldk1, const bf16* K2, int ldk2, const bf16* V, int ldv,
                                          int NT, int qabs0, const LAS float* biasrow, f32x16 (&o)[DV / 32], int tid, int lane, int wave) {
    constexpr int KST = (DQK + 8) * 2, VST = (DV + 8) * 2, KCH = DQK / 8, VCH = DV / 8, NKS = DQK / 16, NCB = DV / 32;
    constexpr int KS_OFF = 0, VS_OFF = 64 * KST;
    static_assert(VS_OFF + 64 * VST <= ATT_WSF_OFF, "attention LDS map");
    const int r32 = lane & 31, hi = lane >> 5;
    bf16x8 qf[NKS];
#pragma unroll
    for (int ks = 0; ks < NKS; ++ks) qf[ks] = *(const GAS bf16x8*)(Qp + 16 * ks + 8 * hi);
#pragma unroll
    for (int cb = 0; cb < NCB; ++cb) o[cb] = f32x16{};
    float m = NEGBIG, l = 0.f;
    const LAS unsigned char* ka = lds + KS_OFF + r32 * KST + hi * 16;
    const LAS unsigned char* va = lds + VS_OFF + (4 * hi + ((lane & 15) >> 2)) * VST + (((lane >> 4) & 1) * 16 + (lane & 3) * 4) * 2;
    LAS float* wsf = (LAS float*)(lds + ATT_WSF_OFF) + wave * 64;
    const LAS float* wsr = wsf + 4 * hi;
    constexpr int NKI = (64 * KCH + NWAVES * 64 - 1) / (NWAVES * 64), NVI = (64 * VCH) / (NWAVES * 64);
    static_assert((64 * VCH) % (NWAVES * 64) == 0, "V tile chunks divide over the workgroup");
    v4u kreg[NKI], vreg[NVI];
#define ATT_PREFETCH(tt) do { const GAS unsigned char* k1t = (const GAS unsigned char*)(K1 + (size_t)(64 * (tt)) * ldk1); const GAS unsigned char* k2t = (const GAS unsigned char*)(K2 + (size_t)(64 * (tt)) * ldk2); \
          const GAS unsigned char* vt = (const GAS unsigned char*)(V + (size_t)(64 * (tt)) * ldv); \
          _Pragma("unroll") for (int i = 0; i < NKI; ++i) { const int c = tid + i * NWAVES * 64; if ((64 * KCH) % (NWAVES * 64) == 0 || c < 64 * KCH) { const int row = c / KCH, ch = c - row * KCH; const int e0 = ch * 8; \
              kreg[i] = (e0 < KW1) ? *(const GAS v4u*)(k1t + (unsigned)((row * ldk1 + e0) * 2)) : *(const GAS v4u*)(k2t + (unsigned)((row * ldk2 + (e0 - KW1)) * 2)); } } \
          _Pragma("unroll") for (int i = 0; i < NVI; ++i) { const int c = tid + i * NWAVES * 64; const int row = c / VCH, ch = c - row * VCH; \
              vreg[i] = *(const GAS v4u*)(vt + (unsigned)((row * ldv + ch * 8) * 2)); } } while (0)
    if (PF) ATT_PREFETCH(0);
    for (int t = 0; t < NT; ++t) {
        __syncthreads();
        if (!PF) ATT_PREFETCH(t);
#pragma unroll
        for (int i = 0; i < NKI; ++i) { const int c = tid + i * NWAVES * 64; if ((64 * KCH) % (NWAVES * 64) == 0 || c < 64 * KCH) { const int row = c / KCH, ch = c - row * KCH; *(LAS v4u*)(lds + KS_OFF + row * KST + ch * 16) = kreg[i]; } }
#pragma unroll
        for (int i = 0; i < NVI; ++i) { const int c = tid + i * NWAVES * 64; const int row = c / VCH, ch = c - row * VCH; *(LAS v4u*)(lds + VS_OFF + row * VST + ch * 16) = vreg[i]; }
        __syncthreads();
        if (PF) { if (t + 1 < NT) ATT_PREFETCH(t + 1); }
        if (CAUSAL && 64 * t > qabs0 + 31) continue;
        f32x16 p0 = f32x16{}, p1 = f32x16{};
#pragma unroll
        for (int ks = 0; ks < NKS; ++ks) {
            const bf16x8 a0 = *(const LAS bf16x8*)(ka + ks * 32), a1 = *(const LAS bf16x8*)(ka + 32 * KST + ks * 32);
            p0 = __builtin_amdgcn_mfma_f32_32x32x16_bf16(a0, qf[ks], p0, 0, 0, 0);
            p1 = __builtin_amdgcn_mfma_f32_32x32x16_bf16(a1, qf[ks], p1, 0, 0, 0);
        }
        const int qrel = qabs0 + r32 - 64 * t - 4 * hi;
        if (BIAS) { if (qabs0 - (64 * t + 63) < 128) {
            const LAS float* bp = biasrow + (qrel + 64 - 59);
#pragma unroll
            for (int r = 0; r < 16; ++r) { constexpr int dummy = 0; const int C = (r & 3) + 8 * (r >> 2); p0[r] += bp[59 - C + dummy]; p1[r] += bp[27 - C]; } } }
        if (CAUSAL) { if (64 * t + 63 > qabs0) {
#pragma unroll
            for (int r = 0; r < 16; ++r) { const int C = (r & 3) + 8 * (r >> 2); if (C > qrel) p0[r] = NEGBIG; if (C + 32 > qrel) p1[r] = NEGBIG; } } }
        float rm = p0[0];
#pragma unroll
        for (int r = 1; r < 16; ++r) rm = fmaxf(rm, p0[r]);
#pragma unroll
        for (int r = 0; r < 16; ++r) rm = fmaxf(rm, p1[r]);
        rm = fmaxf(rm, __shfl_xor(rm, 32));
        const float mn = fmaxf(m, rm), alpha = fexp2(m - mn); m = mn;
        if (hi == 0) wsf[r32] = alpha;
        float rs = 0.f;
#pragma unroll
        for (int r = 0; r < 16; ++r) { p0[r] = fexp2(p0[r] - mn); p1[r] = fexp2(p1[r] - mn); rs += p0[r] + p1[r]; }
        rs += __shfl_xor(rs, 32);
        l = l * alpha + rs;
#pragma unroll
        for (int r = 0; r < 16; ++r) { const float ar = wsr[(r & 3) + 8 * (r >> 2)];
#pragma unroll
            for (int cb = 0; cb < NCB; ++cb) o[cb][r] *= ar; }
        bf16x8 pa[4];
#pragma unroll
        for (int s = 0; s < 2; ++s) {
            v4u w0, w1;
            w0.x = cvtpk(p0[8 * s + 0], p0[8 * s + 1]); w0.y = cvtpk(p0[8 * s + 2], p0[8 * s + 3]); w0.z = cvtpk(p0[8 * s + 4], p0[8 * s + 5]); w0.w = cvtpk(p0[8 * s + 6], p0[8 * s + 7]);
            w1.x = cvtpk(p1[8 * s + 0], p1[8 * s + 1]); w1.y = cvtpk(p1[8 * s + 2], p1[8 * s + 3]); w1.z = cvtpk(p1[8 * s + 4], p1[8 * s + 5]); w1.w = cvtpk(p1[8 * s + 6], p1[8 * s + 7]);
            pa[s] = __builtin_bit_cast(bf16x8, w0); pa[2 + s] = __builtin_bit_cast(bf16x8, w1);
        }
#pragma unroll
        for (int cb = 0; cb < NCB; ++cb)
#pragma unroll
            for (int s = 0; s < 4; ++s) {
                const s16x4 lo = vtr(va + (16 * s) * VST + cb * 64), hh = vtr(va + (16 * s + 8) * VST + cb * 64);
                const bf16x8 vf = {lo[0], lo[1], lo[2], lo[3], hh[0], hh[1], hh[2], hh[3]};
                o[cb] = __builtin_amdgcn_mfma_f32_32x32x16_bf16(pa[s], vf, o[cb], 0, 0, 0);
            }
    }
#undef ATT_PREFETCH
    if (hi == 0) wsf[r32] = 1.0f / l;
#pragma unroll
    for (int r = 0; r < 16; ++r) { const float lr = wsr[(r & 3) + 8 * (r >> 2)];
#pragma unroll
        for (int cb = 0; cb < NCB; ++cb) o[cb][r] *= lr; }
}
template <int NCB> __device__ __forceinline__ void attn_store(bf16* Orow0, int ldo, const f32x16 (&o)[NCB], int lane) {
    const int r32 = lane & 31, hi = lane >> 5;
#pragma unroll
    for (int r = 0; r < 16; ++r)
#pragma unroll
        for (int cb = 0; cb < NCB; ++cb) Orow0[(size_t)crow(r, hi) * ldo + 32 * cb + r32] = (bf16)f2bf(o[cb][r]);
}

__device__ __forceinline__ void attn_phase_mixer(unsigned char* ws, float* out, const float* dng, LAS unsigned char* lds, int vcu, int G, int tid, int lane, int wave, const unsigned* zero_word) {
    { const float* bt = (const float*)(ws + WS_TAB + 256 * 1024); LAS float* lb = (LAS float*)(lds + ATT_BIAS_OFF);
      for (int i = tid; i < 8 * BIAS_PITCH; i += NWAVES * 64) { const int mp = i / BIAS_PITCH, n = i - mp * BIAS_PITCH - 64; lb[i] = (n >= 0 && n < 128) ? bt[mp * 128 + n] : 0.f; } }
    const float lam = ((const float*)(ws + WS_TAB + 260 * 1024))[0];
    __syncthreads();
    const bf16* QMLA = (const bf16*)((unsigned char*)out + OUT_QMLA); const bf16* KVMLA = (const bf16*)(ws + WS_HB); const bf16* KROPE = (const bf16*)(ws + WS_KROPE);
    const bf16* QD = (const bf16*)(ws + WS_QD); const bf16* KD = (const bf16*)(ws + WS_KD); const bf16* VD = (const bf16*)(ws + WS_VD);
    bf16* OMD = (bf16*)((unsigned char*)out + OUT_OMD);
    const int r32 = lane & 31, hi = lane >> 5;
    for (int i = 0; i < 2; ++i) {
        const int d = (i == 0) ? vcu : 511 - vcu; if (vcu >= 256) break;
        const int qb = 7 - (d >> 6), rem = d & 63; const int q0 = 256 * qb, NT = (q0 + 256) / 64, qabs0 = q0 + 32 * wave;
        {
            const int b = rem >> 2, h = rem & 3; const size_t rb = (size_t)b * SEQ, qrow = rb + qabs0 + r32;
            f32x16 o1[4];
            LAS unsigned* park = (LAS unsigned*)(lds + 65536 + wave * 8192) + lane;
            attn_core<64, 128, 64, true, true, true>(lds, QD + qrow * 512 + 128 * h + 64, KD + rb * 512 + 128 * h + 64, 512, nullptr, 0, VD + rb * 512 + 128 * h, 512, NT, qabs0,
                                               (const LAS float*)(lds + ATT_BIAS_OFF) + BIAS_PITCH * (2 * h + 1), o1, tid, lane, wave);
#pragma unroll
            for (int cb = 0; cb < 4; ++cb)
#pragma unroll
                for (int r = 0; r < 8; ++r) park[(cb * 8 + r) * 64] = cvtpk(o1[cb][2 * r], o1[cb][2 * r + 1]);
            attn_core<64, 128, 64, true, true, true>(lds, QD + qrow * 512 + 128 * h, KD + rb * 512 + 128 * h, 512, nullptr, 0, VD + rb * 512 + 128 * h, 512, NT, qabs0,
                                               (const LAS float*)(lds + ATT_BIAS_OFF) + BIAS_PITCH * (2 * h), o1, tid, lane, wave);
            float gg[4];
#pragma unroll
            for (int cb = 0; cb < 4; ++cb) gg[cb] = dng[32 * cb + r32] * (1.0f - LAM_INIT);
#pragma unroll
            for (int r = 0; r < 16; ++r) {
                float ss = 0.f;
#pragma unroll
                for (int cb = 0; cb < 4; ++cb) { const unsigned w = park[(cb * 8 + (r >> 1)) * 64]; const float o2v = __builtin_bit_cast(float, (r & 1) ? (w & 0xffff0000u) : (w << 16));
                    o1[cb][r] -= lam * o2v; ss += o1[cb][r] * o1[cb][r]; }
                ss += __shfl_xor(ss, 1); ss += __shfl_xor(ss, 2); ss += __shfl_xor(ss, 4); ss += __shfl_xor(ss, 8); ss += __shfl_xor(ss, 16);
                const float rinv = 1.0f / sqrtf(ss * (1.0f / 128.0f) + RMS_EPS);
#pragma unroll
                for (int cb = 0; cb < 4; ++cb) o1[cb][r] *= rinv * gg[cb];
            }
            attn_store<4>(OMD + (rb + qabs0) * 1024 + 512 + 128 * h, 1024, o1, lane);
        }
    }
    __syncthreads();
    const int lane2 = (int)((threadIdx.x | *(volatile GAS unsigned*)zero_word) & 63u); const int r32b = lane2 & 31;
    for (int i = 0; i < 4; ++i) {
        const int d = (i & 1) ? 511 - vcu : vcu; if (vcu >= 256) break;
        const int qb = 7 - (d >> 6), rem = (d & 63) + 64 * (i >> 1); const int q0 = 256 * qb, NT = (q0 + 256) / 64, qabs0 = q0 + 32 * wave;
        {
            const int b = rem >> 3, h = rem & 7; const size_t rb = (size_t)b * SEQ, qrow = rb + qabs0 + r32b;
            f32x16 o[2];
            attn_core<96, 64, 64, true, false, true>(lds, QMLA + qrow * 768 + 96 * h, KVMLA + rb * 1024 + 64 * h, 1024, KROPE + rb * 32, 32, KVMLA + rb * 1024 + 512 + 64 * h, 1024, NT, qabs0,
                                               nullptr, o, tid, lane2, wave);
            attn_store<2>(OMD + (rb + qabs0) * 1024 + 64 * h, 1024, o, lane2);
        }
    }
}
__device__ __forceinline__ void attn_phase_mem(unsigned char* ws, LAS unsigned char* lds, int vcu, int G, int tid, int lane, int wave) {
    const bf16* QM = (const bf16*)(ws + WS_QM); const bf16* KVM = (const bf16*)(ws + WS_KVM); bf16* OMEM = (bf16*)(ws + WS_OMEM);
    const int r32 = lane & 31;
    constexpr int NU = BATCH * 4 * 8;
    for (int u = vcu; u < NU; u += G) {
        const int b = u >> 5, h = (u >> 3) & 3, qb = u & 7; const int qabs0 = 256 * qb + 32 * wave; const size_t rb = (size_t)b * SEQ, qrow = rb + qabs0 + r32, kb = (size_t)b * MEML;
#pragma unroll 1
        for (int half = 0; half < 2; ++half) {
            f32x16 o[4];
            attn_core<256, 128, 256, false, false, false>(lds, QM + qrow * 1024 + 256 * h, KVM + kb * 2048 + 256 * h, 2048, nullptr, 0, KVM + kb * 2048 + 1024 + 256 * h + 128 * half, 2048, MEML / 64, qabs0,
                                                   nullptr, o, tid, lane, wave);
            attn_store<4>(OMEM + (rb + qabs0) * 1024 + 256 * h + 128 * half, 1024, o, lane);
        }
    }
}

struct Args { const float* in[35]; float* out; unsigned char* ws; int ph_lo, ph_hi; };
__global__ void __launch_bounds__(NWAVES * 64, 2) mk_fwd(Args args) {
    extern __shared__ __attribute__((aligned(16))) unsigned char lds_raw[];
    LAS unsigned char* lds = (LAS unsigned char*)lds_raw;
    volatile LAS unsigned* MISC = (volatile LAS unsigned*)(lds + MISC_OFF);
    const int tid = threadIdx.x, lane = tid & 63, wave = __builtin_amdgcn_readfirstlane(tid >> 6);
    const int G = gridDim.x; const int bx = blockIdx.x; const int vcu = (G % 8 == 0) ? (bx % 8) * (G / 8) + bx / 8 : bx;
    unsigned char* ws = args.ws; float* out = args.out; const float* const* in = args.in;
    gu32* ctl = (gu32*)(ws + WS_CTL);
    for (int u = tid; u < (LDS_BYTES - LDSCTL_OFF) / 4; u += NWAVES * 64) ((LAS unsigned*)(lds + LDSCTL_OFF))[u] = 0u;
    __syncthreads();
    XcdBarrier bar; bar.bar = (unsigned*)(ctl + CW_BAR); bar.x = 0; bar.st = nullptr;
    if (MK_ONE_LAUNCH) bar = xcd_barrier_post((unsigned*)(ctl + CW_BAR), MISC + 8);
    const int lo = args.ph_lo, hi = args.ph_hi;
#ifndef PH_MASK
#define PH_MASK 0x1ffff
#endif
#define IN(k) ((((PH_MASK) >> (k)) & 1) && lo <= (k) && (k) < hi)
#define OPQ_STR2(x) #x
#define OPQ_STR(x) OPQ_STR2(x)
#define OPQ_TID() const int tid_ = tid; const int lane_ = (int)((threadIdx.x | *(volatile GAS unsigned*)(ctl + 8)) & 63u)
#define SEAM(k) do { if (IN(k) && IN((k) + 1)) xcd_barrier(bar); } while (0)
    const int gw = vcu * NWAVES + wave, NGW = G * NWAVES;
    float* HF = (float*)(ws + WS_HF); bf16* HB = (bf16*)(ws + WS_HB); bf16* U = (bf16*)(ws + WS_U);

    if (IN(PH_PRO)) { OPQ_TID(); p0_prologue(in, ws, lds, vcu, G, wave, lane_, tid_); }
    SEAM(PH_PRO);
    if (IN(PH_FFN1UP)) {
        { pg8::Gemm g{HB, (const bf16*)(ws + WS_W1C1), M, 2 * FF, D}; pg8::StaticOrder S; S.init(M, 2 * FF, G, bx); EpiRow<FSwiglu> E{{U}};
          pg8::gemm_phase<EpiRow<FSwiglu>, pg8::StaticOrder, true, true>(lds + RING_OFF, g, S, E, (const unsigned*)(ctl + 8)); }
        { pg8::Gemm g{(const bf16*)(ws + WS_MEMB), (const bf16*)(ws + WS_WMKV), MM, 2048, D}; pg8::StaticOrder S; S.init(MM, 2048, G, bx); EpiRow<FPlain> E{{(bf16*)(ws + WS_KVM), 2048, 1.0f}};
          pg8::gemm_phase<EpiRow<FPlain>, pg8::StaticOrder, true, true>(lds + RING_OFF, g, S, E, (const unsigned*)(ctl + 8)); }
    }
    SEAM(PH_FFN1UP);
    if (IN(PH_FFN1DN)) {
        pg8::Gemm g{U, (const bf16*)(ws + WS_W21), M, D, FF}; pg8::StaticOrder S; S.init(M, D, G, bx); EpiRow<FResid> E{{in[IN_X], out, 0.5f}};
        pg8::gemm_phase<EpiRow<FResid>, pg8::StaticOrder, true, true>(lds + RING_OFF, g, S, E, (const unsigned*)(ctl + 8));
    }
    SEAM(PH_FFN1DN);
    if (IN(PH_LN1)) { OPQ_TID(); ln_rows(out, in[IN_LN1G], in[IN_LN1B], HF, HB, gw, NGW, lane_); }
    SEAM(PH_LN1);
    if (IN(PH_PROJ)) {
        pg8::Gemm g{HB, (const bf16*)(ws + WS_WPG), M, NPG, D}; pg8::StaticOrder S; S.init(M, NPG, G, bx);
        EpiRow<FProj> E{{(bf16*)((unsigned char*)out + OUT_CQ), (bf16*)((unsigned char*)out + OUT_CKV), (bf16*)(ws + WS_KROPE), (bf16*)(ws + WS_QD), (bf16*)(ws + WS_G),
                         (float*)(ws + WS_SSQQ), (float*)(ws + WS_SSQKV), in[IN_BGATE], (const float*)(ws + WS_TAB)}};
        pg8::gemm_phase<EpiRow<FProj>, pg8::StaticOrder, true, true>(lds + RING_OFF, g, S, E, (const unsigned*)(ctl + 8));
    }
    SEAM(PH_PROJ);
    if (IN(PH_QKVUP)) {
#ifndef NO_QUP
        { pg8::Gemm g{(const bf16*)((unsigned char*)out + OUT_CQ), (const bf16*)(ws + WS_WQB), M, 768, QR}; pg8::StaticOrder S; S.init(M, 768, G, bx);
          EpiRow<FQup> E{{(bf16*)((unsigned char*)out + OUT_QMLA), (const float*)(ws + WS_SSQQ), (const float*)(ws + WS_TAB)}};
          pg8::gemm_phase<EpiRow<FQup>, pg8::StaticOrder, true, true>(lds + RING_OFF, g, S, E, (const unsigned*)(ctl + 8)); }
#endif
#ifndef NO_KVUP
        { pg8::Gemm g{(const bf16*)((unsigned char*)out + OUT_CKV), (const bf16*)(ws + WS_WKVB), M, 1024, KVR}; pg8::StaticOrder S; S.init(M, 1024, G, bx);
          EpiRow<FKVup> E{{HB, (const float*)(ws + WS_SSQKV)}};
          pg8::gemm_phase<EpiRow<FKVup>, pg8::StaticOrder, true, true>(lds + RING_OFF, g, S, E, (const unsigned*)(ctl + 8)); }
#endif
    }
    SEAM(PH_QKVUP);
    if (IN(PH_ATTN)) { OPQ_TID(); attn_phase_mixer(ws, out, in[IN_DNG], lds, vcu, G, tid_, lane_, wave, (const unsigned*)(ctl + 8)); }
#if defined(DUP_ATTN)
    if (IN(PH_ATTN)) { xcd_barrier(bar); OPQ_TID(); attn_phase_mixer(ws, out, in[IN_DNG], lds, vcu, G, tid_, lane_, wave, (const unsigned*)(ctl + 8)); }
#endif
    SEAM(PH_ATTN);
    if (IN(PH_YG)) {
        pg8::Gemm g{(const bf16*)((unsigned char*)out + OUT_OMD), (const bf16*)(ws + WS_WY), M, 2048, D}; pg8::StaticOrder S; S.init(M, 2048, G, bx); EpiRow<FYGate> E{{HB, (const bf16*)(ws + WS_G)}};
        pg8::gemm_phase<EpiRow<FYGate>, pg8::StaticOrder, true, true>(lds + RING_OFF, g, S, E, (const unsigned*)(ctl + 8));
    }
    SEAM(PH_YG);
    if (IN(PH_WO)) {
        pg8::Gemm g{HB, (const bf16*)(ws + WS_WO), M, D, D}; pg8::StaticOrder S; S.init(M, D, G, bx); EpiRow<FResid> E{{HF, out, 1.0f}};
        pg8::gemm_phase<EpiRow<FResid>, pg8::StaticOrder, true, true>(lds + RING_OFF, g, S, E, (const unsigned*)(ctl + 8));
    }
    SEAM(PH_WO);
    if (IN(PH_LN2)) { OPQ_TID(); ln_rows(out, in[IN_LN2G], in[IN_LN2B], HF, HB, gw, NGW, lane_); }
    SEAM(PH_LN2);
    if (IN(PH_MEMQ)) {
        pg8::Gemm g{HB, (const bf16*)(ws + WS_WMQ), M, D, D}; pg8::StaticOrder S; S.init(M, D, G, bx); EpiRow<FPlain> E{{(bf16*)(ws + WS_QM), D, C2_MEM}};
        pg8::gemm_phase<EpiRow<FPlain>, pg8::StaticOrder, true, true>(lds + RING_OFF, g, S, E, (const unsigned*)(ctl + 8));
    }
    SEAM(PH_MEMQ);
    if (IN(PH_MEMATT)) { OPQ_TID(); attn_phase_mem(ws, lds, vcu, G, tid_, lane_, wave); }
#if defined(DUP_MEMATT)
    if (IN(PH_MEMATT)) { xcd_barrier(bar); OPQ_TID(); attn_phase_mem(ws, lds, vcu, G, tid_, lane_, wave); }
#endif
    SEAM(PH_MEMATT);
    if (IN(PH_MEMO)) {
        pg8::Gemm g{(const bf16*)(ws + WS_OMEM), (const bf16*)(ws + WS_WMO), M, D, D}; pg8::StaticOrder S; S.init(M, D, G, bx); EpiRow<FResid> E{{HF, out, 1.0f}};
        pg8::gemm_phase<EpiRow<FResid>, pg8::StaticOrder, true, true>(lds + RING_OFF, g, S, E, (const unsigned*)(ctl + 8));
    }
    SEAM(PH_MEMO);
    if (IN(PH_LN3)) { OPQ_TID(); ln_rows(out, in[IN_LN3G], in[IN_LN3B], HF, HB, gw, NGW, lane_); }
    SEAM(PH_LN3);
    if (IN(PH_FFN2UP)) {
        pg8::Gemm g{HB, (const bf16*)(ws + WS_W1C2), M, 2 * FF, D}; pg8::StaticOrder S; S.init(M, 2 * FF, G, bx); EpiRow<FSwiglu> E{{U}};
        pg8::gemm_phase<EpiRow<FSwiglu>, pg8::StaticOrder, true, true>(lds + RING_OFF, g, S, E, (const unsigned*)(ctl + 8));
    }
    SEAM(PH_FFN2UP);
    if (IN(PH_FFN2DN)) {
        pg8::Gemm g{U, (const bf16*)(ws + WS_W22), M, D, FF}; pg8::StaticOrder S; S.init(M, D, G, bx); EpiRow<FResid> E{{HF, out, 0.5f}};
        pg8::gemm_phase<EpiRow<FResid>, pg8::StaticOrder, true, true>(lds + RING_OFF, g, S, E, (const unsigned*)(ctl + 8));
    }
    SEAM(PH_FFN2DN);
    if (IN(PH_LN4)) { OPQ_TID(); ln_rows(out, in[IN_LN4G], in[IN_LN4B], out, nullptr, gw, NGW, lane_); }
#undef IN
#undef SEAM
}

extern "C" void kernel_launch(void* const* d_in, const int* in_sizes, int n_in, void* d_out, int out_size, void* d_ws, size_t ws_size, hipStream_t stream) {
    static int grid = 0;
    if (grid == 0) {
        if (n_in != 35 || in_sizes[0] != M * D || out_size != M * D || ws_size < WS_END) { fprintf(stderr, "kernel_launch: unexpected shapes (n_in %d, in0 %d, out %d, ws %zu); nothing launched\n", n_in, n_in > 0 ? in_sizes[0] : -1, out_size, ws_size); grid = -1; return; }
        int dev = 0, cus = 0, per_cu = 0;
        if (hipGetDevice(&dev) != hipSuccess || hipDeviceGetAttribute(&cus, hipDeviceAttributeMultiprocessorCount, dev) != hipSuccess) { grid = -1; return; }
        if (hipFuncSetAttribute((const void*)mk_fwd, hipFuncAttributeMaxDynamicSharedMemorySize, LDS_BYTES) != hipSuccess) { fprintf(stderr, "kernel_launch: hipFuncSetAttribute failed\n"); grid = -1; return; }
        if (hipOccupancyMaxActiveBlocksPerMultiprocessor(&per_cu, (const void*)mk_fwd, NWAVES * 64, LDS_BYTES) != hipSuccess || per_cu < 1) { fprintf(stderr, "kernel_launch: occupancy query says %d blocks per CU\n", per_cu); per_cu = 1; }
        (void)hipGetLastError();
        grid = cus * (per_cu < 1 ? 1 : 1);
        if (grid != 256) { fprintf(stderr, "kernel_launch: this kernel's unit maps need exactly 256 workgroups (one per CU of a 256-CU device); device has %d CUs; nothing launched\n", cus); grid = -1; return; }
    }
    if (grid < 0) return;
    if (hipMemsetAsync((char*)d_ws + WS_CTL, 0, CTL_ZERO_BYTES, stream) != hipSuccess) { fprintf(stderr, "kernel_launch: hipMemsetAsync failed\n"); return; }
    Args a{};
    for (int i = 0; i < 35; ++i) a.in[i] = (const float*)d_in[i];
    a.out = (float*)d_out; a.ws = (unsigned char*)d_ws;
#if MK_ONE_LAUNCH
    a.ph_lo = 0; a.ph_hi = NPHASE;
    { void* kargs[] = {(void*)&a};
      hipError_t e = hipLaunchCooperativeKernel((const void*)mk_fwd, dim3(grid), dim3(NWAVES * 64), kargs, LDS_BYTES, stream);
      if (e != hipSuccess) { fprintf(stderr, "kernel_launch: cooperative launch failed: %s (grid %d)\n", hipGetErrorString(e), grid); } }
#else
    for (int p = 0; p < NPHASE; ++p) { a.ph_lo = p; a.ph_hi = p + 1; hipLaunchKernelGGL(mk_fwd, dim3(grid), dim3(NWAVES * 64), LDS_BYTES, stream, a); }
#endif
}
```
